# Optimizing an MI355X kernel written in HIP

```python
import jax, jax.numpy as jnp
from jax import lax
import numpy as np

D_MODEL = 4096
BATCH = 4
SEQ = 2048
DEPTH = 1

CHUNK = 64
LEFT_CHUNKS = 8
BAND = (LEFT_CHUNKS + 1) * CHUNK
ATTN_HEAD_DIM = 128
ATTN_HEADS = (D_MODEL // 2) // ATTN_HEAD_DIM
ATTN_WIDTH = ATTN_HEADS * ATTN_HEAD_DIM
MAX_REL_DIST = 256
RET_V_DIM = 256
RET_HEADS = (D_MODEL // 2) // RET_V_DIM
RET_QK_DIM = RET_V_DIM // 2
RET_QK_WIDTH = RET_HEADS * RET_QK_DIM
RET_WIDTH = RET_HEADS * RET_V_DIM
ROPE_BASE = 10000.0
MIX_WIDTH = ATTN_WIDTH + RET_WIDTH
IN_SIZES = (ATTN_WIDTH, ATTN_WIDTH, ATTN_WIDTH, RET_QK_WIDTH, RET_QK_WIDTH, RET_WIDTH, RET_WIDTH)
IN_WIDTH = 3 * ATTN_WIDTH + 2 * RET_QK_WIDTH + 2 * RET_WIDTH
MEM_LEN = 256
XATTN_HEADS = 4
XATTN_HEAD_DIM = D_MODEL // XATTN_HEADS
PEER_HEADS = 8
PEER_KEYS = 128
PEER_EXPERTS = PEER_KEYS * PEER_KEYS
PEER_QUERY_DIM = 256
PEER_HALF = PEER_QUERY_DIM // 2
PEER_TOPK = 16
PEER_TOKEN_BLOCK = 64

EPS = 1e-6
NEG_INF = -1e30

kernel_name = "hybrid_chunkattn_retention_peer_block"


def rms_norm(x, w):
    xf = x.astype(jnp.float32)
    y = xf * lax.rsqrt(jnp.mean(xf * xf, axis=-1, keepdims=True) + EPS)
    return (y * w.astype(jnp.float32)).astype(x.dtype)


def split_columns(t, sizes):
    parts, start = [], 0
    for size in sizes:
        parts.append(t[..., start:start + size])
        start += size
    return parts


def rotary(x, pos):
    d = x.shape[-1]
    inv_freq = 1.0 / (ROPE_BASE ** (jnp.arange(0, d, 2, dtype=jnp.float32) / d))
    ang = pos.astype(jnp.float32)[:, None] * inv_freq[None, :]
    cos = jnp.cos(ang)[None, :, None, :]
    sin = jnp.sin(ang)[None, :, None, :]
    xf = x.astype(jnp.float32)
    x1, x2 = xf[..., : d // 2], xf[..., d // 2:]
    return jnp.concatenate([x1 * cos - x2 * sin, x1 * sin + x2 * cos], axis=-1).astype(x.dtype)


def chunked_rel_attention(q, k, v, rel_bias):
    B, S, H, dh = q.shape
    nc = S // CHUNK

    def to_chunks(t):
        return t.reshape(B, nc, CHUNK, H, dh).transpose(0, 3, 1, 2, 4)

    pad = ((0, 0), (0, 0), (LEFT_CHUNKS, 0), (0, 0), (0, 0))
    qc = to_chunks(q) * (dh ** -0.5)
    kp = jnp.pad(to_chunks(k), pad)
    vp = jnp.pad(to_chunks(v), pad)
    qi = jnp.arange(CHUNK)[:, None]
    band = jnp.arange(BAND)[None, :]
    dist = LEFT_CHUNKS * CHUNK + qi - band
    bias = rel_bias[:, jnp.clip(dist, -MAX_REL_DIST, MAX_REL_DIST) + MAX_REL_DIST]
    src_chunk = jnp.arange(nc)[:, None] - LEFT_CHUNKS + jnp.arange(LEFT_CHUNKS + 1)[None, :]
    valid = jnp.repeat(src_chunk >= 0, CHUNK, axis=1)
    scores = jnp.concatenate(
        [jnp.einsum('bhncd,bhnmd->bhncm', qc, kp[:, :, j:j + nc]) for j in range(LEFT_CHUNKS + 1)],
        axis=-1).astype(jnp.float32)
    scores = scores + bias[None, :, None].astype(jnp.float32)
    scores = jnp.where(valid[None, None, :, None, :], scores, NEG_INF)
    probs = jax.nn.softmax(scores, axis=-1).astype(v.dtype)
    out = jnp.einsum('bhncm,bhnmd->bhncd', probs[..., :CHUNK], vp[:, :, 0:nc])
    for j in range(1, LEFT_CHUNKS + 1):
        out = out + jnp.einsum('bhncm,bhnmd->bhncd',
                               probs[..., j * CHUNK:(j + 1) * CHUNK], vp[:, :, j:j + nc])
    return out.transpose(0, 2, 3, 1, 4).reshape(B, S, H * dh)


def chunkwise_retention(q, k, v, gate, gn_w):
    B, S, H, dk = q.shape
    dv = v.shape[-1]
    nc = S // CHUNK
    dt = q.dtype
    log_gamma = jnp.log1p(-jnp.power(2.0, -5.0 - jnp.arange(H, dtype=jnp.float32)))
    pos = jnp.arange(CHUNK, dtype=jnp.float32)
    inner_decay = jnp.exp(log_gamma[:, None, None] * jnp.abs(pos[:, None] - pos[None, :]))
    q_decay = jnp.exp(log_gamma[:, None] * (pos + 1.0))
    k_decay = jnp.exp(log_gamma[:, None] * (CHUNK - 1.0 - pos))
    chunk_decay = jnp.exp(log_gamma * CHUNK)[None, :, None, None]

    qc = q.reshape(B, nc, CHUNK, H, dk).transpose(0, 3, 1, 2, 4)
    kc = k.reshape(B, nc, CHUNK, H, dk).transpose(0, 3, 1, 2, 4) * (dk ** -0.5)
    vc = v.reshape(B, nc, CHUNK, H, dv).transpose(0, 3, 1, 2, 4)

    inner = jnp.einsum('bhncd,bhnmd->bhncm', qc, kc) * inner_decay[None, :, None].astype(dt)
    inner = jnp.einsum('bhncm,bhnme->bhnce', inner, vc)
    kv = jnp.einsum('bhncd,bhnce->nbhde',
                    kc * k_decay[None, :, None, :, None].astype(dt), vc)

    def step(state, kv_n):
        return state * chunk_decay + kv_n, state

    _, states = lax.scan(step, jnp.zeros((B, H, dk, dv), jnp.float32), kv.astype(jnp.float32))
    cross = jnp.einsum('bhncd,nbhde->bhnce',
                       qc * q_decay[None, :, None, :, None].astype(dt), states.astype(dt))
    y = (inner + cross).transpose(0, 2, 3, 1, 4).astype(jnp.float32)
    mu = jnp.mean(y, axis=-1, keepdims=True)
    var = jnp.mean(jnp.square(y - mu), axis=-1, keepdims=True)
    yn = ((y - mu) * lax.rsqrt(var + EPS)).reshape(B, S, H * dv) * gn_w.astype(jnp.float32)
    return (jax.nn.silu(gate.astype(jnp.float32)) * yn).astype(dt)


def memory_cross_attention(h, mem_n, wq, wkv, wo):
    B, S, D = h.shape
    M = mem_n.shape[1]
    q = (h @ wq).reshape(B, S, XATTN_HEADS, XATTN_HEAD_DIM)
    k, v = split_columns(mem_n @ wkv, (D, D))
    k = k.reshape(B, M, XATTN_HEADS, XATTN_HEAD_DIM)
    v = v.reshape(B, M, XATTN_HEADS, XATTN_HEAD_DIM)
    s = jnp.einsum('bshd,bmhd->bhsm', q, k).astype(jnp.float32) * (XATTN_HEAD_DIM ** -0.5)
    p = jax.nn.softmax(s, axis=-1).astype(v.dtype)
    o = jnp.einsum('bhsm,bmhd->bshd', p, v).reshape(B, S, D)
    return o @ wo


def peer_ffn(h, wq, subkeys, u, v):
    B, S, D = h.shape
    T = B * S
    x = h.reshape(T, D)
    q = (x @ wq).reshape(T, PEER_HEADS, 2, PEER_HALF)
    s = jnp.einsum('thpd,hpkd->thpk', q, subkeys).astype(jnp.float32)
    top_s, top_i = lax.top_k(s, PEER_TOPK)
    cand_s = top_s[:, :, 0, :, None] + top_s[:, :, 1, None, :]
    cand_i = top_i[:, :, 0, :, None] * PEER_KEYS + top_i[:, :, 1, None, :]
    best_s, best_c = lax.top_k(cand_s.reshape(T, PEER_HEADS, PEER_TOPK * PEER_TOPK), PEER_TOPK)
    expert_idx = jnp.take_along_axis(
        cand_i.reshape(T, PEER_HEADS, PEER_TOPK * PEER_TOPK), best_c, axis=-1)
    gates = jax.nn.softmax(best_s, axis=-1).astype(h.dtype)
    nb = T // PEER_TOKEN_BLOCK
    xb = x.reshape(nb, PEER_TOKEN_BLOCK, D)
    ib = expert_idx.reshape(nb, PEER_TOKEN_BLOCK, PEER_HEADS * PEER_TOPK)
    gb = gates.reshape(nb, PEER_TOKEN_BLOCK, PEER_HEADS * PEER_TOPK)

    def block(args):
        xt, idx, g = args
        act = jax.nn.gelu(jnp.einsum('td,tkd->tk', xt, u[idx]), approximate=False)
        return jnp.einsum('tk,tkd->td', g * act, v[idx])

    out = lax.map(block, (xb, ib, gb))
    return out.reshape(B, S, D)


def setup_inputs(seed: int = 0) -> dict:
    key = jax.random.key(seed)
    ks = jax.random.split(key, 18)
    f32 = jnp.float32
    L = DEPTH

    def nrm(k, shape, scale):
        return jax.random.normal(k, shape, f32) * scale

    def gain(k, shape):
        return 1.0 + 0.01 * jax.random.normal(k, shape, f32)

    return {
        "x": nrm(ks[0], (BATCH, SEQ, D_MODEL), 1.0),
        "mem": nrm(ks[1], (BATCH, MEM_LEN, D_MODEL), 1.0),
        "norm1_w": gain(ks[2], (L, D_MODEL)),
        "w_in": nrm(ks[3], (L, D_MODEL, IN_WIDTH), D_MODEL ** -0.5),
        "attn_rel_bias": nrm(ks[4], (L, ATTN_HEADS, 2 * MAX_REL_DIST + 1), 0.1),
        "ret_gn_w": gain(ks[5], (L, RET_WIDTH)),
        "w_out": nrm(ks[6], (L, MIX_WIDTH, D_MODEL), MIX_WIDTH ** -0.5),
        "norm2_w": gain(ks[7], (L, D_MODEL)),
        "mem_norm_w": gain(ks[8], (L, D_MODEL)),
        "xattn_wq": nrm(ks[9], (L, D_MODEL, D_MODEL), D_MODEL ** -0.5),
        "xattn_wkv": nrm(ks[10], (L, D_MODEL, 2 * D_MODEL), D_MODEL ** -0.5),
        "xattn_wo": nrm(ks[11], (L, D_MODEL, D_MODEL), D_MODEL ** -0.5),
        "norm3_w": gain(ks[12], (L, D_MODEL)),
        "peer_wq": nrm(ks[13], (L, D_MODEL, PEER_HEADS * PEER_QUERY_DIM), D_MODEL ** -0.5),
        "peer_subkeys": nrm(ks[14], (L, PEER_HEADS, 2, PEER_KEYS, PEER_HALF), PEER_HALF ** -0.5),
        "peer_u": nrm(ks[15], (L, PEER_EXPERTS, D_MODEL), D_MODEL ** -0.5),
        "peer_v": nrm(ks[16], (L, PEER_EXPERTS, D_MODEL), PEER_HEADS ** -0.5),
        "final_norm_w": gain(ks[17], (D_MODEL,)),
    }


def reference(x, mem, norm1_w, w_in, attn_rel_bias, ret_gn_w, w_out, norm2_w, mem_norm_w,
              xattn_wq, xattn_wkv, xattn_wo, norm3_w, peer_wq, peer_subkeys, peer_u, peer_v,
              final_norm_w):
    B, S, _ = x.shape
    pos = jnp.arange(S)
    h = x
    for l in range(DEPTH):
        xn = rms_norm(h, norm1_w[l])
        aq, ak, av, rq, rk, rv, rg = split_columns(xn @ w_in[l], IN_SIZES)
        a_out = chunked_rel_attention(
            aq.reshape(B, S, ATTN_HEADS, ATTN_HEAD_DIM),
            ak.reshape(B, S, ATTN_HEADS, ATTN_HEAD_DIM),
            av.reshape(B, S, ATTN_HEADS, ATTN_HEAD_DIM),
            attn_rel_bias[l])
        r_out = chunkwise_retention(
            rotary(rq.reshape(B, S, RET_HEADS, RET_QK_DIM), pos),
            rotary(rk.reshape(B, S, RET_HEADS, RET_QK_DIM), pos),
            rv.reshape(B, S, RET_HEADS, RET_V_DIM),
            rg, ret_gn_w[l])
        h = h + jnp.concatenate([a_out, r_out], axis=-1) @ w_out[l]
        mem_n = rms_norm(mem, mem_norm_w[l])
        h = h + memory_cross_attention(rms_norm(h, norm2_w[l]), mem_n,
                                       xattn_wq[l], xattn_wkv[l], xattn_wo[l])
        h = h + peer_ffn(rms_norm(h, norm3_w[l]), peer_wq[l], peer_subkeys[l], peer_u[l], peer_v[l])
    return rms_norm(h, final_norm_w)
```

```cpp
#include <hip/hip_runtime.h>
#include <cstdio>
#include <cstdint>

#ifndef MK_PER_PHASE
#define MK_PER_PHASE 0
#endif
#ifndef PROBE_ORDER
#define PROBE_ORDER 0,1,2,3,4,5,6,7,8,9,10,11,12
#define PROBE_SUBS  7,7,7,7,7,7,7,7,7,7,7,7,7
#endif

#define LAS __attribute__((address_space(3)))
#define GAS __attribute__((address_space(1)))
typedef unsigned short bf16;
typedef short bf16x8 __attribute__((ext_vector_type(8)));
typedef float f32x4 __attribute__((ext_vector_type(4)));
typedef float f32x2 __attribute__((ext_vector_type(2)));
typedef unsigned u32x4 __attribute__((ext_vector_type(4)));
typedef unsigned u32x2 __attribute__((ext_vector_type(2)));

constexpr int D = 4096, NB = 4, SEQ = 2048, T = NB * SEQ;
constexpr int MEM = 256, TM = NB * MEM;
constexpr int NEXP = 16384;
constexpr float EPS = 1e-6f;
constexpr float LOG2E = 1.4426950408889634f;

typedef __bf16 bf16x2v __attribute__((ext_vector_type(2)));
__device__ __forceinline__ unsigned cvt_pk_bf16(float lo, float hi) { const f32x2 v = {lo, hi}; return __builtin_bit_cast(unsigned, __builtin_convertvector(v, bf16x2v)); }
typedef int i32x4 __attribute__((ext_vector_type(4)));
typedef int i32x8 __attribute__((ext_vector_type(8)));
__device__ __forceinline__ float f8c(float x) { return fminf(fmaxf(x, -448.0f), 448.0f); }
__device__ __forceinline__ unsigned pk4_fp8(float a, float b, float c, float d) { int r = __builtin_amdgcn_cvt_pk_fp8_f32(f8c(a), f8c(b), 0, false); r = __builtin_amdgcn_cvt_pk_fp8_f32(f8c(c), f8c(d), r, true); return (unsigned)r; }
__device__ __forceinline__ float bf_lo(unsigned w) { return __builtin_bit_cast(float, w << 16); }
__device__ __forceinline__ float bf_hi(unsigned w) { return __builtin_bit_cast(float, w & 0xffff0000u); }

constexpr int PQ_WAVE = 2752, PQ_CAP = PQ_WAVE / 32;
namespace pg8 {
constexpr int BM = 256, BK = 64, HALF = 128, HTB = HALF * BK * 2, STAGE_BYTES = 8 * HTB, NXCD = 8, WGM = 8;
__host__ __device__ __forceinline__ int lds_byte(int r, int c) { const int st = (r >> 4) * 2 + (c >> 5), rr = r & 15, cc = c & 31, ob = rr * 64 + cc * 2; return st * 1024 + (ob ^ (((ob >> 9) & 1) << 5)); }
__host__ __device__ __forceinline__ void stage_rc(int b, int& R, int& C) { const int st = b / 1024, sb = b % 1024, swz = sb ^ (((sb >> 9) & 1) << 5); R = (st >> 1) * 16 + swz / 64; C = (st & 1) * 32 + (swz % 64) / 2; }
__host__ __device__ __forceinline__ int perm32(int rho) { const int n = rho >> 4, i = rho & 15; return 8 * (i >> 2) + 4 * n + (i & 3); }

struct Unit { int pm, pn, orow, ocol, kind; };
struct Gemm { const bf16* A; const bf16* Bt; int lda, ldb, K; };

struct TileOrder {
    int nM, nN, nwg, G, c;
    __device__ __forceinline__ void init(int nM_, int nN_, int G_, int c_) { nM = nM_; nN = nN_; nwg = nM * nN; G = G_; c = c_; }
    __device__ __forceinline__ bool tile(int i, int& pm, int& pn) const {
        const long L = (long)i * G + c; if (L >= nwg) return false;
        int wgid = (int)L; { const int q = nwg / NXCD, r = nwg % NXCD, xcd = wgid % NXCD, off = wgid / NXCD; wgid = (xcd < r ? xcd * (q + 1) : r * (q + 1) + (xcd - r) * q) + off; }
        const int nig = WGM * nN, gid = wgid / nig, fm = gid * WGM, gsz = (nM - fm) < WGM ? (nM - fm) : WGM;
        pm = fm + ((wgid % nig) % gsz); pn = (wgid % nig) / gsz; return true;
    }
};
struct SchedPlain : TileOrder {
    __device__ __forceinline__ bool next(int i, Unit& u) const { if (!tile(i, u.pm, u.pn)) return false; u.orow = u.pm * BM; u.ocol = u.pn * BM; return true; }
    __device__ __forceinline__ size_t offA(const Unit& u, const Gemm& g) const { return (size_t)u.pm * BM * g.lda * 2; }
    __device__ __forceinline__ size_t offB(const Unit& u, const Gemm& g) const { return (size_t)u.pn * BM * g.ldb * 2; }
};
struct SchedWp : TileOrder {
    int es;
    __device__ __forceinline__ bool next(int i, Unit& u) const { if (!tile(i, u.pm, u.pn)) return false; u.orow = u.pm * BM; u.ocol = u.pn * BM; return true; }
    __device__ __forceinline__ size_t offA(const Unit& u, const Gemm&) const { return ((size_t)(u.pm >> 2) * 256 * 8192 + (size_t)(u.pm & 3) * 1024) * es; }
    __device__ __forceinline__ size_t offB(const Unit& u, const Gemm&) const { return ((size_t)u.pn * 256 * 4096 + (size_t)(u.pm & 3) * 1024) * es; }
};
struct SchedVp : TileOrder {
    int es;
    __device__ __forceinline__ bool next(int i, Unit& u) const { if (!tile(i, u.pm, u.pn)) return false; u.orow = (u.pn >> 2) * 4096 + u.pm * BM; u.ocol = (u.pn & 3) * BM; return true; }
    __device__ __forceinline__ size_t offA(const Unit& u, const Gemm&) const { return ((size_t)u.pm * 256 * 4096 + (size_t)(u.pn & 3) * 1024) * es; }
    __device__ __forceinline__ size_t offB(const Unit& u, const Gemm&) const { return ((size_t)(u.pn >> 2) * 256 * 8192 + 4096 + (size_t)(u.pn & 3) * 1024) * es; }
};
struct SchedS : TileOrder {
    int es;
    __device__ __forceinline__ bool next(int i, Unit& u) const { if (!tile(i, u.pm, u.pn)) return false; u.orow = u.pm * BM; u.ocol = u.pn * BM; return true; }
    __device__ __forceinline__ size_t offA(const Unit& u, const Gemm&) const { return (size_t)u.pm * 256 * 4096 * es; }
    __device__ __forceinline__ size_t offB(const Unit& u, const Gemm&) const { return ((size_t)(u.pm >> 3) * 1024 + (size_t)u.pn * 256) * 4096 * es; }
};
struct SchedO : TileOrder {
    int es;
    __device__ __forceinline__ bool next(int i, Unit& u) const { if (!tile(i, u.pm, u.pn)) return false; u.orow = u.pm * BM; u.ocol = u.pn * BM; return true; }
    __device__ __forceinline__ size_t offA(const Unit& u, const Gemm&) const { return (size_t)u.pm * 256 * 1024 * es; }
    __device__ __forceinline__ size_t offB(const Unit& u, const Gemm&) const { return ((size_t)(u.pm >> 3) * 4096 + (size_t)u.pn * 256) * 1024 * es; }
};

struct SchedP1 {
    int G, c; size_t x8, win8, memn8, wkv8;
    __device__ __forceinline__ static void tile_lin(int wgid, int nM, int nN, int& pm, int& pn) {
        const int nwg = nM * nN; { const int q = nwg / NXCD, r = nwg % NXCD, xcd = wgid % NXCD, off = wgid / NXCD; wgid = (xcd < r ? xcd * (q + 1) : r * (q + 1) + (xcd - r) * q) + off; }
        const int nig = WGM * nN, gid = wgid / nig, fm = gid * WGM, gsz = (nM - fm) < WGM ? (nM - fm) : WGM;
        pm = fm + ((wgid % nig) % gsz); pn = (wgid % nig) / gsz;
    }
    __device__ __forceinline__ bool next(int i, Unit& u) const {
        const long L = (long)i * G + c; if (L >= 1152) return false;
        int l = (int)L, k, nM, nN;
        if (l < 512) { k = 0; nM = 32; nN = 16; } else if (l < 768) { k = 2; l -= 512; nM = 8; nN = 32; }
        else if (l < 1024) { k = 3; l -= 768; nM = 8; nN = 32; } else { k = 4; l -= 1024; nM = 4; nN = 32; }
        tile_lin(l, nM, nN, u.pm, u.pn); u.orow = u.pm * BM; u.ocol = u.pn * BM; u.kind = k; return true;
    }
    __device__ __forceinline__ size_t offA(const Unit& u, const Gemm&) const { const size_t t = (size_t)u.pm * BM * 4096;
        return u.kind < 2 ? x8 + t : u.kind == 2 ? win8 + (size_t)4096 * 4096 + t : u.kind == 3 ? win8 + (size_t)6144 * 4096 + t : memn8 + t; }
    __device__ __forceinline__ size_t offB(const Unit& u, const Gemm&) const { const size_t t = (size_t)u.pn * BM * 4096;
        return u.kind == 0 ? win8 + t : u.kind == 1 ? win8 + (size_t)8192 * 4096 + t : u.kind < 4 ? x8 + t : wkv8 + t; }
};

__device__ __forceinline__ f32x2 gelu_pk(f32x2 v) {
    const f32x2 av = __builtin_elementwise_abs(v), d = av * 0.2316418882f + 1.0f;
    f32x2 t; t.x = __builtin_amdgcn_rcpf(d.x); t.y = __builtin_amdgcn_rcpf(d.y);
    f32x2 q = t * 0.5307027145f + (-0.7265760135f); q = q * t + 0.7107068705f; q = q * t + (-0.142248368f); q = q * t + 0.127414796f; q = q * t;
    const f32x2 s = (v * v) * (-0.72134752044f);
    f32x2 e; e.x = __builtin_amdgcn_exp2f(s.x); e.y = __builtin_amdgcn_exp2f(s.y);
    const f32x2 pos = {fmaxf(v.x, 0.f), fmaxf(v.y, 0.f)};
    return pos - av * (q * e);
}

struct EpiBf16S {
    static constexpr bool PERM = true, HAS_BEGIN = false;
    bf16* O; int ldc; float scale;
    __device__ __forceinline__ void operator()(f32x4 (&acc)[2][2][4][2], const Unit& u, int wr, int wc, int fr, int fq, int par) const {
        const int row0 = u.orow + wr * 64 + fr, col0 = u.ocol + wc * 32 + 8 * fq;
#pragma unroll
        for (int ai = 0; ai < 2; ++ai)
#pragma unroll
            for (int m = 0; m < 4; ++m) { bf16* rowp = O + (size_t)(row0 + ai * HALF + m * 16) * ldc + col0;
#pragma unroll
                for (int bj = 0; bj < 2; ++bj) { const f32x4 v0 = acc[ai][bj][m][0] * scale, v1 = acc[ai][bj][m][1] * scale;
                    u32x4 w; w.x = cvt_pk_bf16(v0[0], v0[1]); w.y = cvt_pk_bf16(v0[2], v0[3]); w.z = cvt_pk_bf16(v1[0], v1[1]); w.w = cvt_pk_bf16(v1[2], v1[3]);
                    *(u32x4*)(rowp + bj * HALF) = w; } }
    }
};
__device__ __forceinline__ float row_rs(const float* rowpart, int row) {
    const f32x4* p = (const f32x4*)(rowpart + (size_t)row * 16); const f32x4 a = p[0], b = p[1], c = p[2], d = p[3];
    const float s = (((a[0] + a[1]) + (a[2] + a[3])) + ((b[0] + b[1]) + (b[2] + b[3]))) + (((c[0] + c[1]) + (c[2] + c[3])) + ((d[0] + d[1]) + (d[2] + d[3])));
    return 1.0f / sqrtf(s * (1.0f / 4096.0f) + 1e-6f);
}
__device__ __forceinline__ void rs_begin(const float* rowpart, LAS unsigned char* rs_tab, int orow, int par) { const int t = threadIdx.x; if (t < 256) ((LAS float*)rs_tab)[par * 256 + t] = row_rs(rowpart, orow + t); }
template <bool BASE_BF16> struct EpiResNorm {
    static constexpr bool PERM = true, HAS_BEGIN = false;
    const void* base; bf16* hb; unsigned char* x8; float* rowpart; LAS unsigned char* xch;
    __device__ __forceinline__ void operator()(f32x4 (&acc)[2][2][4][2], const Unit& u, int wr, int wc, int fr, int fq, int par) const {
        const int row0 = u.orow + wr * 64 + fr, col0 = u.ocol + wc * 32 + 8 * fq;
        LAS float* X = (LAS float*)xch;
#pragma unroll
        for (int ai = 0; ai < 2; ++ai)
#pragma unroll
            for (int m = 0; m < 4; ++m) { const size_t off = (size_t)(row0 + ai * HALF + m * 16) * 4096 + col0;
                f32x4 bs[2][2];
#pragma unroll
                for (int bj = 0; bj < 2; ++bj) {
                    if constexpr (BASE_BF16) { const u32x4 w = *(const u32x4*)((const bf16*)base + off + bj * HALF);
                        bs[bj][0] = (f32x4){bf_lo(w.x), bf_hi(w.x), bf_lo(w.y), bf_hi(w.y)}; bs[bj][1] = (f32x4){bf_lo(w.z), bf_hi(w.z), bf_lo(w.w), bf_hi(w.w)}; }
                    else { bs[bj][0] = *(const f32x4*)((const float*)base + off + bj * HALF); bs[bj][1] = *(const f32x4*)((const float*)base + off + bj * HALF + 4); } }
                float ss = 0.f;
#pragma unroll
                for (int bj = 0; bj < 2; ++bj) { const f32x4 o0 = bs[bj][0] + acc[ai][bj][m][0], o1 = bs[bj][1] + acc[ai][bj][m][1];
                    ss += ((o0[0] * o0[0] + o0[1] * o0[1]) + (o0[2] * o0[2] + o0[3] * o0[3])) + ((o1[0] * o1[0] + o1[1] * o1[1]) + (o1[2] * o1[2] + o1[3] * o1[3]));
                    u32x2 q; q.x = pk4_fp8(16.f * o0[0], 16.f * o0[1], 16.f * o0[2], 16.f * o0[3]); q.y = pk4_fp8(16.f * o1[0], 16.f * o1[1], 16.f * o1[2], 16.f * o1[3]);
                    *(u32x2*)(x8 + off + bj * HALF) = q;
                    u32x4 w; w.x = cvt_pk_bf16(o0[0], o0[1]); w.y = cvt_pk_bf16(o0[2], o0[3]); w.z = cvt_pk_bf16(o1[0], o1[1]); w.w = cvt_pk_bf16(o1[2], o1[3]); *(u32x4*)(hb + off + bj * HALF) = w; }
                ss += __shfl_xor(ss, 16); ss += __shfl_xor(ss, 32);
                if (fq == 0) X[(ai * HALF + wr * 64 + m * 16 + fr) * 4 + wc] = ss;
                asm volatile("" ::: "memory"); }
        asm volatile("s_waitcnt lgkmcnt(0)" ::: "memory"); __builtin_amdgcn_s_barrier(); asm volatile("" ::: "memory");
        if (wc == 0 && fq == 0) {
#pragma unroll
            for (int ai = 0; ai < 2; ++ai)
#pragma unroll
                for (int m = 0; m < 4; ++m) { const int rl = ai * HALF + wr * 64 + m * 16 + fr; const f32x4 p = *(const LAS f32x4*)(X + rl * 4);
                    rowpart[(size_t)(u.orow + rl) * 16 + u.pn] = (p[0] + p[1]) + (p[2] + p[3]); }
        }
    }
};
struct EpiResBf16 {
    static constexpr bool PERM = true, HAS_BEGIN = false;
    bf16* hb;
    __device__ __forceinline__ void operator()(f32x4 (&acc)[2][2][4][2], const Unit& u, int wr, int wc, int fr, int fq, int par) const {
        const int row0 = u.orow + wr * 64 + fr, col0 = u.ocol + wc * 32 + 8 * fq;
#pragma unroll
        for (int ai = 0; ai < 2; ++ai)
#pragma unroll
            for (int m = 0; m < 4; ++m) { bf16* rowp = hb + (size_t)(row0 + ai * HALF + m * 16) * 4096 + col0;
                u32x4 bw[2];
#pragma unroll
                for (int bj = 0; bj < 2; ++bj) bw[bj] = *(const u32x4*)(rowp + bj * HALF);
#pragma unroll
                for (int bj = 0; bj < 2; ++bj) { const u32x4 b = bw[bj]; const f32x4 v0 = acc[ai][bj][m][0], v1 = acc[ai][bj][m][1];
                    u32x4 w; w.x = cvt_pk_bf16(bf_lo(b.x) + v0[0], bf_hi(b.x) + v0[1]); w.y = cvt_pk_bf16(bf_lo(b.y) + v0[2], bf_hi(b.y) + v0[3]);
                    w.z = cvt_pk_bf16(bf_lo(b.z) + v1[0], bf_hi(b.z) + v1[1]); w.w = cvt_pk_bf16(bf_lo(b.w) + v1[2], bf_hi(b.w) + v1[3]); *(u32x4*)(rowp + bj * HALF) = w; }
                asm volatile("" ::: "memory"); }
    }
};
struct EpiBf16VT {
    static constexpr bool PERM = true, HAS_BEGIN = false;
    bf16* O; int dvlog2, H;
    __device__ __forceinline__ void operator()(f32x4 (&acc)[2][2][4][2], const Unit& u, int wr, int wc, int fr, int fq, int par) const {
        const int row0 = u.orow + wr * 64 + fr, col0 = u.ocol + wc * 32 + 8 * fq;
#pragma unroll
        for (int ai = 0; ai < 2; ++ai)
#pragma unroll
            for (int m = 0; m < 4; ++m) { const int n = row0 + ai * HALF + m * 16; const int h = n >> dvlog2, d = n & ((1 << dvlog2) - 1);
#pragma unroll
                for (int bj = 0; bj < 2; ++bj) { const int t = col0 + bj * HALF; const int b = t >> 11, mc = (t >> 6) & 31, i = t & 63;
                    const f32x4 v0 = acc[ai][bj][m][0], v1 = acc[ai][bj][m][1];
                    const int p0 = (i & 32) + 16 * ((i >> 3) & 1) + 4 * ((i >> 4) & 1);
                    u32x2 w0, w1; w0.x = cvt_pk_bf16(v0[0], v0[1]); w0.y = cvt_pk_bf16(v0[2], v0[3]); w1.x = cvt_pk_bf16(v1[0], v1[1]); w1.y = cvt_pk_bf16(v1[2], v1[3]);
                    bf16* rp = O + ((((size_t)(b * H + h) * 32 + mc) << dvlog2) + d) * 64 + p0; *(u32x2*)rp = w0; *(u32x2*)(rp + 8) = w1; } }
    }
};
struct EpiBf16QK {
    static constexpr bool PERM = true, HAS_BEGIN = false;
    bf16* O; int ldc; bf16* KT;
    __device__ __forceinline__ void operator()(f32x4 (&acc)[2][2][4][2], const Unit& u, int wr, int wc, int fr, int fq, int par) const {
        const int row0 = u.orow + wr * 64 + fr, col0 = u.ocol + wc * 32 + 8 * fq;
#pragma unroll
        for (int ai = 0; ai < 2; ++ai)
#pragma unroll
            for (int m = 0; m < 4; ++m) { const int row = row0 + ai * HALF + m * 16; const int b = row >> 11, mc = (row >> 6) & 31, i = row & 63;
#pragma unroll
                for (int bj = 0; bj < 2; ++bj) { const f32x4 v0 = acc[ai][bj][m][0], v1 = acc[ai][bj][m][1];
                    u32x4 w; w.x = cvt_pk_bf16(v0[0], v0[1]); w.y = cvt_pk_bf16(v0[2], v0[3]); w.z = cvt_pk_bf16(v1[0], v1[1]); w.w = cvt_pk_bf16(v1[2], v1[3]);
                    if (u.ocol < 2048) *(u32x4*)(O + (size_t)row * ldc + col0 + bj * HALF) = w;
                    else { const int h = ((u.ocol - 2048) >> 7) + bj, d = wc * 32 + 8 * fq; *(u32x4*)(KT + ((((size_t)(b * 16 + h) * 32 + mc) * 64 + i) << 7) + d) = w; } } }
    }
};
struct EpiBf16Rot {
    static constexpr bool PERM = true, HAS_BEGIN = false;
    bf16* O; int ldc; bf16* KT;
    __device__ __forceinline__ void operator()(f32x4 (&acc)[2][2][4][2], const Unit& u, int wr, int wc, int fr, int fq, int par) const {
        const int row0 = u.orow + wr * 64 + fr;
        if (u.ocol < 2048) {
            const int d0 = 32 * (wc & 1) + 8 * fq; float invf[8];
#pragma unroll
            for (int e = 0; e < 8; ++e) invf[e] = __builtin_amdgcn_exp2f((float)(d0 + e) * (-13.287712379549449f / 64.0f)) * 0.15915494309189535f;
            bf16* obase = O + u.ocol + (wc >> 1) * 128 + d0;
#pragma unroll
            for (int ai = 0; ai < 2; ++ai)
#pragma unroll
                for (int m = 0; m < 4; ++m) { const int row = row0 + ai * HALF + m * 16; const float pos = (float)(row & (SEQ - 1));
                    float lo[8], hi[8];
#pragma unroll
                    for (int e = 0; e < 8; ++e) { const float rev = pos * invf[e], frc = rev - floorf(rev); const float sn = __builtin_amdgcn_sinf(frc), cs = __builtin_amdgcn_cosf(frc);
                        const float x1 = acc[ai][0][m][e >> 2][e & 3], x2 = acc[ai][1][m][e >> 2][e & 3]; lo[e] = x1 * cs - x2 * sn; hi[e] = x1 * sn + x2 * cs; }
                    u32x4 wl, wh; wl.x = cvt_pk_bf16(lo[0], lo[1]); wl.y = cvt_pk_bf16(lo[2], lo[3]); wl.z = cvt_pk_bf16(lo[4], lo[5]); wl.w = cvt_pk_bf16(lo[6], lo[7]);
                    wh.x = cvt_pk_bf16(hi[0], hi[1]); wh.y = cvt_pk_bf16(hi[2], hi[3]); wh.z = cvt_pk_bf16(hi[4], hi[5]); wh.w = cvt_pk_bf16(hi[6], hi[7]);
                    if (u.ocol < 1024) { bf16* rowp = obase + (size_t)row * ldc; *(u32x4*)rowp = wl; *(u32x4*)(rowp + 64) = wh; }
                    else { const int b = row >> 11, mc = (row >> 6) & 31, i = row & 63, h = ((u.ocol - 1024) >> 7) + (wc >> 1);
                        bf16* kp = KT + ((((size_t)(b * 8 + h) * 32 + mc) * 64 + i) << 7) + d0; *(u32x4*)kp = wl; *(u32x4*)(kp + 64) = wh; } }
        } else {
            const int col0 = u.ocol + wc * 32 + 8 * fq;
#pragma unroll
            for (int ai = 0; ai < 2; ++ai)
#pragma unroll
                for (int m = 0; m < 4; ++m) { bf16* rowp = O + (size_t)(row0 + ai * HALF + m * 16) * ldc + col0;
#pragma unroll
                    for (int bj = 0; bj < 2; ++bj) { const f32x4 v0 = acc[ai][bj][m][0], v1 = acc[ai][bj][m][1];
                        u32x4 w; w.x = cvt_pk_bf16(v0[0], v0[1]); w.y = cvt_pk_bf16(v0[2], v0[3]); w.z = cvt_pk_bf16(v1[0], v1[1]); w.w = cvt_pk_bf16(v1[2], v1[3]);
                        *(u32x4*)(rowp + bj * HALF) = w; } }
        }
    }
};
struct EpiFp8S {
    static constexpr bool PERM = true, HAS_BEGIN = false;
    unsigned char* O; int ldc; float scale;
    __device__ __forceinline__ void operator()(f32x4 (&acc)[2][2][4][2], const Unit& u, int wr, int wc, int fr, int fq, int par) const {
        const int row0 = u.orow + wr * 64 + fr, col0 = u.ocol + wc * 32 + 8 * fq;
#pragma unroll
        for (int ai = 0; ai < 2; ++ai)
#pragma unroll
            for (int m = 0; m < 4; ++m) { unsigned char* rowp = O + (size_t)(row0 + ai * HALF + m * 16) * ldc + col0;
#pragma unroll
                for (int bj = 0; bj < 2; ++bj) { const f32x4 v0 = acc[ai][bj][m][0] * scale, v1 = acc[ai][bj][m][1] * scale;
                    u32x2 w; w.x = pk4_fp8(v0[0], v0[1], v0[2], v0[3]); w.y = pk4_fp8(v1[0], v1[1], v1[2], v1[3]);
                    *(u32x2*)(rowp + bj * HALF) = w; } }
    }
};
struct EpiP1 {
    static constexpr bool PERM = true, HAS_BEGIN = false;
    EpiBf16QK e0; EpiBf16S e1; EpiBf16VT e2, e3; EpiFp8S e4;
    __device__ __forceinline__ void operator()(f32x4 (&acc)[2][2][4][2], const Unit& u, int wr, int wc, int fr, int fq, int par) const {
        if (u.kind == 0) e0(acc, u, wr, wc, fr, fq, par); else if (u.kind == 1) e1(acc, u, wr, wc, fr, fq, par); else if (u.kind == 2) e2(acc, u, wr, wc, fr, fq, par);
        else if (u.kind == 3) e3(acc, u, wr, wc, fr, fq, par); else e4(acc, u, wr, wc, fr, fq, par);
    }
};
struct EpiF32 {
    static constexpr bool PERM = false, HAS_BEGIN = true;
    float* C; int ldc; const float* rowpart; LAS unsigned char* rs_tab;
    __device__ __forceinline__ void begin(const Unit& u, int par) const { rs_begin(rowpart, rs_tab, u.orow, par); }
    __device__ __forceinline__ void operator()(f32x4 (&acc)[2][2][4][2], const Unit& u, int wr, int wc, int fr, int fq, int par) const {
        const int row0 = u.orow + wr * 64 + fr, col0 = u.ocol + wc * 32 + 4 * fq;
#pragma unroll
        for (int ai = 0; ai < 2; ++ai)
#pragma unroll
            for (int m = 0; m < 4; ++m) { const float rs = ((const LAS float*)rs_tab)[par * 256 + ai * HALF + wr * 64 + m * 16 + fr]; float* rowp = C + (size_t)(row0 + ai * HALF + m * 16) * ldc + col0;
#pragma unroll
                for (int bj = 0; bj < 2; ++bj)
#pragma unroll
                    for (int n = 0; n < 2; ++n) *(f32x4*)(rowp + bj * HALF + n * 16) = acc[ai][bj][m][n] * rs; }
    }
};
struct EpiResF32 {
    static constexpr bool PERM = false, HAS_BEGIN = false;
    const float* base; float* out; int ldc;
    __device__ __forceinline__ void operator()(f32x4 (&acc)[2][2][4][2], const Unit& u, int wr, int wc, int fr, int fq, int par) const {
        const int row0 = u.orow + wr * 64 + fr, col0 = u.ocol + wc * 32 + 4 * fq;
#pragma unroll
        for (int ai = 0; ai < 2; ++ai)
#pragma unroll
            for (int m = 0; m < 4; ++m) { const size_t off = (size_t)(row0 + ai * HALF + m * 16) * ldc + col0;
                f32x4 bs[2][2];
#pragma unroll
                for (int bj = 0; bj < 2; ++bj)
#pragma unroll
                    for (int n = 0; n < 2; ++n) bs[bj][n] = *(const f32x4*)(base + off + bj * HALF + n * 16);
#pragma unroll
                for (int bj = 0; bj < 2; ++bj)
#pragma unroll
                    for (int n = 0; n < 2; ++n) *(f32x4*)(out + off + bj * HALF + n * 16) = bs[bj][n] + acc[ai][bj][m][n];
                asm volatile("" ::: "memory"); }
    }
};
struct EpiSoftmax {
    static constexpr bool PERM = true, HAS_BEGIN = true;
    unsigned char* O; int ldc; LAS unsigned char* xch; float pre; const float* rowpart; LAS unsigned char* rs_tab;
    __device__ __forceinline__ void begin(const Unit& u, int par) const { rs_begin(rowpart, rs_tab, u.orow, par); }
    __device__ __forceinline__ void operator()(f32x4 (&acc)[2][2][4][2], const Unit& u, int wr, int wc, int fr, int fq, int par) const {
        LAS f32x2* X = (LAS f32x2*)xch;
        float mloc[2][4];
#pragma unroll
        for (int ai = 0; ai < 2; ++ai)
#pragma unroll
            for (int m = 0; m < 4; ++m) {
                float mx = -3.0e38f; const float prs = pre * ((const LAS float*)rs_tab)[par * 256 + ai * HALF + wr * 64 + m * 16 + fr];
#pragma unroll
                for (int bj = 0; bj < 2; ++bj)
#pragma unroll
                    for (int n = 0; n < 2; ++n) { const f32x4 x = acc[ai][bj][m][n] * prs; acc[ai][bj][m][n] = x; mx = fmaxf(mx, fmaxf(fmaxf(x[0], x[1]), fmaxf(x[2], x[3]))); }
                mx = fmaxf(mx, __shfl_xor(mx, 16)); mx = fmaxf(mx, __shfl_xor(mx, 32));
                float s = 0.f;
#pragma unroll
                for (int bj = 0; bj < 2; ++bj)
#pragma unroll
                    for (int n = 0; n < 2; ++n) { f32x4 x = acc[ai][bj][m][n];
#pragma unroll
                        for (int j = 0; j < 4; ++j) { x[j] = __builtin_amdgcn_exp2f(x[j] - mx); s += x[j]; }
                        acc[ai][bj][m][n] = x; }
                s += __shfl_xor(s, 16); s += __shfl_xor(s, 32);
                mloc[ai][m] = mx;
                if (fq == 0) X[(ai * HALF + wr * 64 + m * 16 + fr) * 4 + wc] = (f32x2){mx, s};
            }
        asm volatile("s_waitcnt lgkmcnt(0)" ::: "memory"); __builtin_amdgcn_s_barrier(); asm volatile("" ::: "memory");
        const int row0 = u.orow + wr * 64 + fr, col0 = u.ocol + wc * 32 + 8 * fq;
#pragma unroll
        for (int ai = 0; ai < 2; ++ai)
#pragma unroll
            for (int m = 0; m < 4; ++m) {
                const int rl = ai * HALF + wr * 64 + m * 16 + fr;
                const f32x2 p0 = X[rl * 4 + 0], p1 = X[rl * 4 + 1], p2 = X[rl * 4 + 2], p3 = X[rl * 4 + 3];
                const float gm = fmaxf(fmaxf(p0.x, p1.x), fmaxf(p2.x, p3.x));
                const float gl = p0.y * __builtin_amdgcn_exp2f(p0.x - gm) + p1.y * __builtin_amdgcn_exp2f(p1.x - gm) + p2.y * __builtin_amdgcn_exp2f(p2.x - gm) + p3.y * __builtin_amdgcn_exp2f(p3.x - gm);
                const float f = 256.0f * __builtin_amdgcn_exp2f(mloc[ai][m] - gm) / gl;
                unsigned char* rowp = O + (size_t)(row0 + ai * HALF + m * 16) * ldc + col0;
#pragma unroll
                for (int bj = 0; bj < 2; ++bj) { const f32x4 v0 = acc[ai][bj][m][0] * f, v1 = acc[ai][bj][m][1] * f;
                    u32x2 w; w.x = pk4_fp8(v0[0], v0[1], v0[2], v0[3]); w.y = pk4_fp8(v1[0], v1[1], v1[2], v1[3]);
                    *(u32x2*)(rowp + bj * HALF) = w; }
            }
    }
};
struct EpiPeer {
    static constexpr bool PERM = true, HAS_BEGIN = false;
    bf16* GP; int ldc;
    __device__ __forceinline__ void operator()(f32x4 (&acc)[2][2][4][2], const Unit& u, int wr, int wc, int fr, int fq, int par) const {
        const int row0 = u.orow + wr * 64 + fr, col0 = u.ocol + wc * 32 + 8 * fq;
#pragma unroll
        for (int ai = 0; ai < 2; ++ai) {
            u32x4 g[4][2];
#pragma unroll
            for (int m = 0; m < 4; ++m)
#pragma unroll
                for (int bj = 0; bj < 2; ++bj) g[m][bj] = *(const u32x4*)(GP + (size_t)(row0 + ai * HALF + m * 16) * ldc + col0 + bj * HALF);
#pragma unroll
            for (int m = 0; m < 4; ++m) { bf16* rowp = GP + (size_t)(row0 + ai * HALF + m * 16) * ldc + col0;
#pragma unroll
                for (int bj = 0; bj < 2; ++bj) { const f32x4 v0 = acc[ai][bj][m][0], v1 = acc[ai][bj][m][1]; const u32x4 gg = g[m][bj];
                    const f32x2 a = gelu_pk((f32x2){v0[0], v0[1]}), b = gelu_pk((f32x2){v0[2], v0[3]}), c = gelu_pk((f32x2){v1[0], v1[1]}), d = gelu_pk((f32x2){v1[2], v1[3]});
                    u32x4 w; w.x = cvt_pk_bf16(a.x * bf_lo(gg.x), a.y * bf_hi(gg.x)); w.y = cvt_pk_bf16(b.x * bf_lo(gg.y), b.y * bf_hi(gg.y));
                    w.z = cvt_pk_bf16(c.x * bf_lo(gg.z), c.y * bf_hi(gg.z)); w.w = cvt_pk_bf16(d.x * bf_lo(gg.w), d.y * bf_hi(gg.w));
                    *(u32x4*)(rowp + bj * HALF) = w; } }
        }
    }
};

struct EpiPeer8 {
    static constexpr bool PERM = true, HAS_BEGIN = true;
    const unsigned char* G; unsigned char* P8; int ldc; const float* rowpart; LAS unsigned char* rs_tab; LAS unsigned char* pq;
    __device__ __forceinline__ void begin(const Unit& u, int par) const { rs_begin(rowpart, rs_tab, u.orow, par); }
    __device__ __forceinline__ void drain(LAS u32x4* Q, int n, int lane) const {
        for (int r = lane; r < n; r += 64) {
            const u32x4 e0 = Q[2 * r], e1 = Q[2 * r + 1];
            const f32x2 a = gelu_pk((f32x2){bf_lo(e0.x), bf_hi(e0.x)}), b = gelu_pk((f32x2){bf_lo(e0.y), bf_hi(e0.y)}), c = gelu_pk((f32x2){bf_lo(e0.z), bf_hi(e0.z)}), d = gelu_pk((f32x2){bf_lo(e0.w), bf_hi(e0.w)});
            u32x2 w; w.x = pk4_fp8(0.25f * a.x * (float)(e1.x & 255u), 0.25f * a.y * (float)((e1.x >> 8) & 255u), 0.25f * b.x * (float)((e1.x >> 16) & 255u), 0.25f * b.y * (float)(e1.x >> 24));
            w.y = pk4_fp8(0.25f * c.x * (float)(e1.y & 255u), 0.25f * c.y * (float)((e1.y >> 8) & 255u), 0.25f * d.x * (float)((e1.y >> 16) & 255u), 0.25f * d.y * (float)(e1.y >> 24));
            *(u32x2*)(P8 + e1.z) = w;
        }
    }
    __device__ __forceinline__ void operator()(f32x4 (&acc)[2][2][4][2], const Unit& u, int wr, int wc, int fr, int fq, int par) const {
        const int row0 = u.orow + wr * 64 + fr, col0 = u.ocol + wc * 32 + 8 * fq, lane = 16 * fq + fr;
        LAS u32x4* Q = (LAS u32x4*)(pq + (wr * 4 + wc) * PQ_WAVE);
        u32x2 g2[2][4][2];
#pragma unroll
        for (int ai = 0; ai < 2; ++ai)
#pragma unroll
            for (int m = 0; m < 4; ++m)
#pragma unroll
                for (int bj = 0; bj < 2; ++bj) g2[ai][m][bj] = *(const u32x2*)(G + (size_t)(row0 + ai * HALF + m * 16) * ldc + col0 + bj * HALF);
        int n = 0;
#pragma unroll
        for (int ai = 0; ai < 2; ++ai)
#pragma unroll
            for (int m = 0; m < 4; ++m) { const float rs = ((const LAS float*)rs_tab)[par * 256 + ai * HALF + wr * 64 + m * 16 + fr]; const unsigned roff = (unsigned)(row0 + ai * HALF + m * 16) * (unsigned)ldc + (unsigned)col0;
#pragma unroll
                for (int bj = 0; bj < 2; ++bj) { const u32x2 gg = g2[ai][m][bj]; const bool nz = (gg.x | gg.y) != 0u;
                    const unsigned long long mask = __ballot(nz);
                    if (mask != 0ull) {
                        const int cnt = __builtin_popcountll(mask);
                        if (n + cnt > PQ_CAP) { drain(Q, n, lane); n = 0; }
                        if (nz) { const int pos = n + (int)__builtin_amdgcn_mbcnt_hi((unsigned)(mask >> 32), __builtin_amdgcn_mbcnt_lo((unsigned)mask, 0u));
                            const f32x4 v0 = acc[ai][bj][m][0] * rs, v1 = acc[ai][bj][m][1] * rs;
                            u32x4 e0; e0.x = cvt_pk_bf16(v0[0], v0[1]); e0.y = cvt_pk_bf16(v0[2], v0[3]); e0.z = cvt_pk_bf16(v1[0], v1[1]); e0.w = cvt_pk_bf16(v1[2], v1[3]);
                            Q[2 * pos] = e0; Q[2 * pos + 1] = (u32x4){gg.x, gg.y, roff + (unsigned)(bj * HALF), 0u}; }
                        n += cnt;
                    } } }
        drain(Q, n, lane);
    }
};

template <class Epi, class Sched, bool FP8 = false, int SC8 = 127, bool ALIGN_EPI = true, bool SP2 = true>
__device__ __forceinline__ void gemm_phase(LAS unsigned char* lds, const Gemm g, const Sched& S, const Epi& E) {
    const int tid = threadIdx.x, wid = __builtin_amdgcn_readfirstlane(tid >> 6), lane = tid & 63, wr = wid >> 2, wc = wid & 3, fr = lane & 15, fq = lane >> 4;
    const int K = g.K, nt = K / BK;
    unsigned voffA[2], voffB[2];
#pragma unroll
    for (int i = 0; i < 2; ++i) { int R, C; stage_rc(tid * 16 + i * 8192, R, C); const int Rb = Epi::PERM ? ((R & ~31) + perm32(R & 31)) : R;
        voffA[i] = (unsigned)(R * g.lda + C) * 2u; voffB[i] = (unsigned)(Rb * g.ldb + C) * 2u; }
    const size_t kstep = (size_t)(BK * 2);
    const size_t hstepA = (size_t)HALF * g.lda * 2, hstepB = (size_t)HALF * g.ldb * 2;
    const unsigned ldsw = (unsigned)wid * 1024u;
    const int aoff = lds_byte(wr * 64 + fr, fq * 8), boff = lds_byte(wc * 32 + fr, fq * 8);
#define PG8_SA(b, h) (((b) * 2 + (h)) * HTB)
#define PG8_SB(b, h) ((4 + (b) * 2 + (h)) * HTB)
#define PG8_STAGE(bufoff, gbase, voff) do { _Pragma("unroll") for (int _i = 0; _i < 2; ++_i) \
        __builtin_amdgcn_global_load_lds((const unsigned*)((const char*)(gbase) + (voff)[_i]), (LAS unsigned*)(lds + (bufoff) + ldsw + _i * 8192), 16, 0, 0); } while (0)
#define PG8_LDA(dst, b, h) do { _Pragma("unroll") for (int m = 0; m < 4; ++m) dst[m] = __builtin_shufflevector(*(const LAS i32x4*)(lds + PG8_SA(b, h) + aoff + m * 2048), *(const LAS i32x4*)(lds + PG8_SA(b, h) + aoff + m * 2048 + 1024), 0, 1, 2, 3, 4, 5, 6, 7); } while (0)
#define PG8_LDB(dst, b, h) do { _Pragma("unroll") for (int n = 0; n < 2; ++n) dst[n] = __builtin_shufflevector(*(const LAS i32x4*)(lds + PG8_SB(b, h) + boff + n * 2048), *(const LAS i32x4*)(lds + PG8_SB(b, h) + boff + n * 2048 + 1024), 0, 1, 2, 3, 4, 5, 6, 7); } while (0)
#define PG8_H0(v) __builtin_bit_cast(bf16x8, __builtin_shufflevector(v, v, 0, 1, 2, 3))
#define PG8_H1(v) __builtin_bit_cast(bf16x8, __builtin_shufflevector(v, v, 4, 5, 6, 7))
#define PG8_MMA(ai, bj, At, Bt) do { __builtin_amdgcn_s_setprio(1); \
        if constexpr (FP8) { _Pragma("unroll") for (int m = 0; m < 4; ++m) _Pragma("unroll") for (int n = 0; n < 2; ++n) \
            asm volatile("v_mfma_scale_f32_16x16x128_f8f6f4 %0, %1, %2, %0, %3, %4 op_sel_hi:[0,0,0]" : "+v"(acc[ai][bj][m][n]) : "v"(Bt[n]), "v"(At[m]), "v"(sc8a), "v"(sc8b)); } \
        else { _Pragma("unroll") for (int m = 0; m < 4; ++m) _Pragma("unroll") for (int n = 0; n < 2; ++n) { \
            acc[ai][bj][m][n] = __builtin_amdgcn_mfma_f32_16x16x32_bf16(PG8_H0(Bt[n]), PG8_H0(At[m]), acc[ai][bj][m][n], 0, 0, 0); \
            acc[ai][bj][m][n] = __builtin_amdgcn_mfma_f32_16x16x32_bf16(PG8_H1(Bt[n]), PG8_H1(At[m]), acc[ai][bj][m][n], 0, 0, 0); } } __builtin_amdgcn_s_setprio(0); } while (0)
#define PG8_WAIT_V(n) asm volatile("s_waitcnt vmcnt(" #n ")" ::: "memory")
#define PG8_WAIT_L(n) asm volatile("s_waitcnt lgkmcnt(" #n ")" ::: "memory")
#define PG8_BAR __builtin_amdgcn_s_barrier()
#define PG8_SCHED __builtin_amdgcn_sched_barrier(0)
    Unit cur, nxt; int ui = 0;
    if (!S.next(0, cur)) return;
    f32x4 acc[2][2][4][2];
#pragma unroll
    for (int a = 0; a < 2; ++a)
#pragma unroll
        for (int b = 0; b < 2; ++b)
#pragma unroll
            for (int m = 0; m < 4; ++m)
#pragma unroll
                for (int n = 0; n < 2; ++n) acc[a][b][m][n] = (f32x4){0.f, 0.f, 0.f, 0.f};
    i32x8 At[4], B0[2], B1[2];
    const int sc8a = SC8, sc8b = 127;
    const char* cA = (const char*)g.A + S.offA(cur, g); const char* cB = (const char*)g.Bt + S.offB(cur, g);
    if constexpr (Epi::HAS_BEGIN) E.begin(cur, 0);
    if constexpr (SP2) {
        PG8_STAGE(PG8_SB(0, 0), cB, voffB); PG8_STAGE(PG8_SB(0, 1), cB + hstepB, voffB); PG8_STAGE(PG8_SA(0, 0), cA, voffA); PG8_STAGE(PG8_SA(0, 1), cA + hstepA, voffA);
        if (wr == 1) PG8_BAR;
        PG8_WAIT_V(2); PG8_BAR;
        PG8_STAGE(PG8_SB(1, 0), cB + kstep, voffB); PG8_STAGE(PG8_SA(1, 0), cA + kstep, voffA); PG8_STAGE(PG8_SB(1, 1), cB + hstepB + kstep, voffB);
        PG8_WAIT_V(6); PG8_BAR;
    } else {
        PG8_STAGE(PG8_SB(0, 0), cB, voffB); PG8_STAGE(PG8_SA(0, 0), cA, voffA); PG8_STAGE(PG8_SB(0, 1), cB + hstepB, voffB); PG8_STAGE(PG8_SA(0, 1), cA + hstepA, voffA);
        if (wr == 1) PG8_BAR;
        PG8_WAIT_V(4); PG8_BAR;
        PG8_STAGE(PG8_SB(1, 0), cB + kstep, voffB); PG8_STAGE(PG8_SA(1, 0), cA + kstep, voffA); PG8_STAGE(PG8_SB(1, 1), cB + hstepB + kstep, voffB);
        PG8_WAIT_V(6); PG8_BAR;
    }
    for (;;) {
        const bool has_next = S.next(ui + 1, nxt);
        const char* nA = has_next ? (const char*)g.A + S.offA(nxt, g) : cA; const char* nB = has_next ? (const char*)g.Bt + S.offB(nxt, g) : cB;
        for (int t = 0; t < nt; t += 2) {
            const bool last = (t == nt - 2);
            const char* a1 = cA + (size_t)(t + 1) * kstep;
            const char* a2 = last ? nA : cA + (size_t)(t + 2) * kstep; const char* b2 = last ? nB : cB + (size_t)(t + 2) * kstep;
            const char* a3 = a2 + kstep; const char* b3 = b2 + kstep;
            if constexpr (SP2) {
            PG8_LDB(B0, 0, 0); PG8_LDB(B1, 0, 1); PG8_SCHED; PG8_LDA(At, 0, 0); PG8_STAGE(PG8_SA(1, 1), a1 + hstepA, voffA);
            PG8_WAIT_V(8); PG8_WAIT_L(0); PG8_BAR; PG8_MMA(0, 0, At, B0); PG8_MMA(0, 1, At, B1); PG8_BAR; PG8_SCHED;
            PG8_LDA(At, 0, 1); PG8_STAGE(PG8_SB(0, 0), b2, voffB); PG8_STAGE(PG8_SB(0, 1), b2 + hstepB, voffB); PG8_STAGE(PG8_SA(0, 0), a2, voffA);
            PG8_WAIT_V(8); PG8_WAIT_L(0); PG8_BAR; PG8_MMA(1, 0, At, B0); PG8_MMA(1, 1, At, B1); PG8_BAR; PG8_SCHED;
            PG8_LDB(B0, 1, 0); PG8_LDB(B1, 1, 1); PG8_SCHED; PG8_LDA(At, 1, 0); PG8_STAGE(PG8_SA(0, 1), a2 + hstepA, voffA);
            PG8_WAIT_V(8); PG8_WAIT_L(0); PG8_BAR; PG8_MMA(0, 0, At, B0); PG8_MMA(0, 1, At, B1); PG8_BAR; PG8_SCHED;
            PG8_LDA(At, 1, 1); PG8_STAGE(PG8_SB(1, 0), b3, voffB); PG8_STAGE(PG8_SB(1, 1), b3 + hstepB, voffB); PG8_STAGE(PG8_SA(1, 0), a3, voffA);
            PG8_WAIT_V(8); PG8_WAIT_L(0); PG8_BAR; PG8_MMA(1, 0, At, B0); PG8_MMA(1, 1, At, B1); PG8_BAR; PG8_SCHED;
            } else {
            PG8_LDB(B0, 0, 0); PG8_SCHED; PG8_LDA(At, 0, 0); PG8_STAGE(PG8_SA(1, 1), a1 + hstepA, voffA);
            PG8_WAIT_L(8); PG8_BAR; PG8_WAIT_L(0); PG8_MMA(0, 0, At, B0); PG8_BAR; PG8_SCHED;
            PG8_LDB(B1, 0, 1); PG8_STAGE(PG8_SB(0, 0), b2, voffB);
            PG8_BAR; PG8_WAIT_L(0); PG8_MMA(0, 1, At, B1); PG8_BAR;
            PG8_LDA(At, 0, 1); PG8_STAGE(PG8_SA(0, 0), a2, voffA);
            PG8_BAR; PG8_WAIT_L(0); PG8_MMA(1, 0, At, B0); PG8_BAR; PG8_SCHED;
            PG8_STAGE(PG8_SB(0, 1), b2 + hstepB, voffB);
            PG8_WAIT_V(6); PG8_BAR; PG8_MMA(1, 1, At, B1); PG8_BAR;
            PG8_LDB(B0, 1, 0); PG8_SCHED; PG8_LDA(At, 1, 0); PG8_STAGE(PG8_SA(0, 1), a2 + hstepA, voffA);
            PG8_WAIT_L(8); PG8_BAR; PG8_WAIT_L(0); PG8_MMA(0, 0, At, B0); PG8_BAR; PG8_SCHED;
            PG8_LDB(B1, 1, 1); PG8_STAGE(PG8_SB(1, 0), b3, voffB);
            PG8_BAR; PG8_WAIT_L(0); PG8_MMA(0, 1, At, B1); PG8_BAR;
            PG8_LDA(At, 1, 1); PG8_STAGE(PG8_SA(1, 0), a3, voffA);
            PG8_BAR; PG8_WAIT_L(0); PG8_MMA(1, 0, At, B0); PG8_BAR; PG8_SCHED;
            PG8_STAGE(PG8_SB(1, 1), b3 + hstepB, voffB);
            PG8_WAIT_V(6); PG8_BAR; PG8_MMA(1, 1, At, B1); PG8_BAR;
            }
        }
        if constexpr (ALIGN_EPI) { if (wr == 0) PG8_BAR; }
        if constexpr (FP8) asm volatile("s_nop 15\n\ts_nop 15" ::: "memory");
        { int ln_ = (int)__builtin_amdgcn_mbcnt_hi(~0u, __builtin_amdgcn_mbcnt_lo(~0u, 0u)); asm volatile("" : "+v"(ln_));
          E(acc, cur, wr, wc, ln_ & 15, ln_ >> 4, ui & 1); }
        if (!has_next) break;
#pragma unroll
        for (int a = 0; a < 2; ++a)
#pragma unroll
            for (int b = 0; b < 2; ++b)
#pragma unroll
                for (int m = 0; m < 4; ++m)
#pragma unroll
                    for (int n = 0; n < 2; ++n) acc[a][b][m][n] = (f32x4){0.f, 0.f, 0.f, 0.f};
        cur = nxt; cA = nA; cB = nB; ++ui;
        if constexpr (Epi::HAS_BEGIN) E.begin(cur, ui & 1);
        if constexpr (ALIGN_EPI) { if (wr == 1) PG8_BAR; }
    }
    PG8_WAIT_V(0);
    if constexpr (!ALIGN_EPI) { if (wr == 0) PG8_BAR; }
    PG8_BAR;
#undef PG8_SA
#undef PG8_SB
#undef PG8_STAGE
#undef PG8_LDA
#undef PG8_LDB
#undef PG8_MMA
#undef PG8_H0
#undef PG8_H1
#undef PG8_WAIT_V
#undef PG8_WAIT_L
#undef PG8_BAR
#undef PG8_SCHED
}
}

constexpr size_t MiB = 1u << 20;
constexpr size_t WS_CTL = 0, CTL_ZERO_BYTES = 1 * MiB;
constexpr size_t WS_WIN = 2 * MiB;
constexpr size_t WS_WOUT = 98 * MiB;
constexpr size_t WS_WQ = 130 * MiB;
constexpr size_t WS_WKV = 162 * MiB;
constexpr size_t WS_WO = 226 * MiB;
constexpr size_t WS_WPP = 258 * MiB;
constexpr size_t WS_U = 274 * MiB;
constexpr size_t WS_VT = 402 * MiB;
constexpr size_t WS_XN = 530 * MiB;
constexpr size_t WS_MEMN = 594 * MiB;
constexpr size_t WS_KVM = 602 * MiB;
constexpr size_t WS_WP = 618 * MiB;
constexpr size_t WS_VPT = 650 * MiB;
constexpr size_t WS_PX = 682 * MiB;
constexpr size_t WS_SC = 698 * MiB;
constexpr size_t WS_R1 = 762 * MiB;
constexpr size_t WS_QKVN = WS_R1;
constexpr size_t WS_VTA = WS_R1 + 128 * MiB;
constexpr size_t WS_MIX = WS_R1 + 192 * MiB;
constexpr size_t WS_GP = WS_R1;
constexpr size_t WS_X8 = WS_U + 64 * MiB;
constexpr size_t WS_P8 = 1018 * MiB;
constexpr size_t WS_END = 1146 * MiB;
constexpr int CW_BAR = 4096;

constexpr int RING_OFF = 0, RING_BYTES = 131072;
constexpr int XCH_OFF = RING_BYTES, XCH_BYTES = 8192 + 2048;
constexpr int RS_OFF = XCH_OFF + 8192;
constexpr int LDSCTL_OFF = XCH_OFF + XCH_BYTES, MISC_OFF = LDSCTL_OFF + 320;
constexpr int PQ_OFF = MISC_OFF + 128;
constexpr int LDS_BYTES = 163840;
static_assert(PQ_OFF + 8 * PQ_WAVE <= LDS_BYTES && PQ_OFF % 16 == 0, "LDS map");
constexpr int NWAVES = 8;

#define RLX_AGENT __ATOMIC_RELAXED, __HIP_MEMORY_SCOPE_AGENT
#define LDS_WAIT() asm volatile("s_waitcnt lgkmcnt(0)" ::: "memory")
#define VM_WAIT() asm volatile("s_waitcnt vmcnt(0)" ::: "memory")

#define XB_TMO      128
#define XB_XCNT(j)  (256  + 64 * (j))
#define XB_XSUB(j)  (1280 + 64 * (j))
#define XB_XGEN(j)  (2304 + 64 * (j))
#define XB_TOP      3328
#define XB_TOPGEN   3392
#define XCD_BAR_WORDS 3456
#define XB_SPIN_CAP (1u << 18)
__device__ __forceinline__ unsigned xb_ld(unsigned* p)              { return __hip_atomic_load(p, __ATOMIC_RELAXED, __HIP_MEMORY_SCOPE_AGENT); }
__device__ __forceinline__ unsigned xb_add(unsigned* p, unsigned v) { return __hip_atomic_fetch_add(p, v, __ATOMIC_RELAXED, __HIP_MEMORY_SCOPE_AGENT); }
__device__ __forceinline__ unsigned xb_xcc_id() { return (unsigned)__builtin_amdgcn_s_getreg((3 << 11) | 20) & 0xFu; }
#define XB_SPIN(cond, bar) do { unsigned _sp = 0; while (cond) { __builtin_amdgcn_s_sleep(1); \
    if ((++_sp & 255u) == 0u) { if (xb_ld(&(bar)[XB_TMO])) break; if (_sp > XB_SPIN_CAP) { atomicAdd(&(bar)[XB_TMO], 1u); break; } } } } while (0)
struct XcdBarrier { unsigned* bar; unsigned x; volatile LAS unsigned* st; };
__device__ __forceinline__ XcdBarrier xcd_barrier_post(unsigned* bar, volatile LAS unsigned* st) {
    XcdBarrier b; b.bar = bar; b.x = xb_xcc_id(); b.st = st;
    if (threadIdx.x == 0) (void)xb_add(&bar[XB_XCNT(b.x)], 1u);
    return b;
}
__device__ __forceinline__ void xcd_barrier_complete(unsigned* bar, unsigned x, unsigned& nloc, unsigned& nx) {
    const unsigned G = gridDim.x * gridDim.y * gridDim.z;
    unsigned sum, cnt, mine, sp = 0u;
    for (;;) {
        sum = 0u; cnt = 0u; mine = 0u;
#pragma unroll
        for (unsigned j = 0; j < 16; ++j) { const unsigned c = xb_ld(&bar[XB_XCNT(j)]); sum += c; cnt += (c > 0u) ? 1u : 0u; mine = (j == x) ? c : mine; }
        if (sum == G) break;
        __builtin_amdgcn_s_sleep(1);
        if ((++sp & 255u) == 0u) { if (xb_ld(&bar[XB_TMO])) break; if (sp > XB_SPIN_CAP) { atomicAdd(&bar[XB_TMO], 1u); break; } }
    }
    nloc = mine > 0u ? mine : 1u; nx = cnt > 0u ? cnt : 1u;
}
__device__ __forceinline__ void xcd_barrier(const XcdBarrier& b) {
    asm volatile("s_waitcnt vmcnt(0)" ::: "memory");
    __syncthreads();
    if (threadIdx.x == 0) {
        unsigned* bar = b.bar;
        __builtin_amdgcn_s_waitcnt(0);
        unsigned nloc = b.st[0], nx = b.st[1];
        if (nloc == 0u) { xcd_barrier_complete(bar, b.x, nloc, nx); b.st[0] = nloc; b.st[1] = nx; }
        const unsigned old = xb_add(&bar[XB_XSUB(b.x)], 1u);
        const unsigned gen = old / nloc;
        if (old + 1u == (gen + 1u) * nloc) {
            __builtin_amdgcn_fence(__ATOMIC_RELEASE, "agent");
            asm volatile("s_waitcnt vmcnt(0)" ::: "memory");
            const unsigned og = xb_add(&bar[XB_TOP], 1u);
            const unsigned tg = og / nx;
            if (og + 1u == (tg + 1u) * nx) xb_add(&bar[XB_TOPGEN], 1u);
            else XB_SPIN(xb_ld(&bar[XB_TOPGEN]) == tg, bar);
            __builtin_amdgcn_fence(__ATOMIC_ACQUIRE, "agent");
            xb_add(&bar[XB_XGEN(b.x)], 1u);
            asm volatile("s_waitcnt vmcnt(0)" ::: "memory");
        } else {
            XB_SPIN(xb_ld(&bar[XB_XGEN(b.x)]) == gen, bar);
            __builtin_amdgcn_fence(__ATOMIC_ACQUIRE, "agent");
            asm volatile("s_waitcnt vmcnt(0)" ::: "memory");
        }
    }
    __syncthreads();
}

__device__ __forceinline__ float wave_sum(float v) {
#pragma unroll
    for (int o = 1; o < 64; o <<= 1) v += __shfl_xor(v, o);
    return v;
}
__device__ __forceinline__ unsigned wave_max_u32(unsigned v) {
#pragma unroll
    for (int o = 1; o < 64; o <<= 1) { const unsigned t = (unsigned)__shfl_xor((int)v, o); v = t > v ? t : v; }
    return v;
}
__device__ __forceinline__ void rot_cs(int pos, int i, float& c, float& s) {
    const float inv_freq = __builtin_amdgcn_exp2f((float)i * (-13.287712379549449f / 64.0f));
    const float ang = (float)pos * inv_freq;
    const float rev = ang * 0.15915494309189535f;
    const float fr = rev - floorf(rev);
    s = __builtin_amdgcn_sinf(fr); c = __builtin_amdgcn_cosf(fr);
}

__device__ __forceinline__ void rms_row_bf16(const float* xrow, const float* w, bf16* orow, int lane) {
    const f32x4* xr = (const f32x4*)xrow + lane; const f32x4* wr = (const f32x4*)w + lane;
    f32x4 v[16]; float ss = 0.f;
#pragma unroll
    for (int j = 0; j < 16; ++j) { v[j] = xr[64 * j]; ss += (v[j].x * v[j].x + v[j].y * v[j].y) + (v[j].z * v[j].z + v[j].w * v[j].w); }
    const float rs = 1.0f / sqrtf(wave_sum(ss) * (1.0f / D) + EPS);
    u32x2* o8 = (u32x2*)orow + lane;
#pragma unroll
    for (int j = 0; j < 16; ++j) { const f32x4 g = wr[64 * j]; u32x2 o; o.x = cvt_pk_bf16(v[j].x * rs * g.x, v[j].y * rs * g.y); o.y = cvt_pk_bf16(v[j].z * rs * g.z, v[j].w * rs * g.w); o8[64 * j] = o; }
}
__device__ __forceinline__ void rms_row_bf16_to_f32(const bf16* hrow, const float* w, float* orow, int lane) {
    const u32x4* hr = (const u32x4*)hrow + lane; const f32x4* wr = (const f32x4*)w + lane * 2;
    u32x4 v[8]; float ss = 0.f;
#pragma unroll
    for (int j = 0; j < 8; ++j) { v[j] = hr[64 * j];
#pragma unroll
        for (int e = 0; e < 4; ++e) { const float a = bf_lo(v[j][e]), b = bf_hi(v[j][e]); ss += a * a + b * b; } }
    const float rs = 1.0f / sqrtf(wave_sum(ss) * (1.0f / D) + EPS);
    f32x4* o4 = (f32x4*)orow + lane * 2;
#pragma unroll
    for (int j = 0; j < 8; ++j) { const f32x4 g0 = wr[128 * j], g1 = wr[128 * j + 1];
        o4[128 * j] = (f32x4){bf_lo(v[j].x), bf_hi(v[j].x), bf_lo(v[j].y), bf_hi(v[j].y)} * rs * g0;
        o4[128 * j + 1] = (f32x4){bf_lo(v[j].z), bf_hi(v[j].z), bf_lo(v[j].w), bf_hi(v[j].w)} * rs * g1; }
}
__device__ __forceinline__ void rms_row_f32_inplace(float* xrow, const float* w, int lane) {
    f32x4* xr = (f32x4*)xrow + lane; const f32x4* wr = (const f32x4*)w + lane;
    f32x4 v[16]; float ss = 0.f;
#pragma unroll
    for (int j = 0; j < 16; ++j) { v[j] = xr[64 * j];
#ifdef DBG_SCRUB
        for (int e = 0; e < 4; ++e) if (!(fabsf(v[j][e]) < 1.0e30f)) v[j][e] = 0.f;
#endif
        ss += (v[j].x * v[j].x + v[j].y * v[j].y) + (v[j].z * v[j].z + v[j].w * v[j].w); }
    const float rs = 1.0f / sqrtf(wave_sum(ss) * (1.0f / D) + EPS);
#pragma unroll
    for (int j = 0; j < 16; ++j) { const f32x4 g = wr[64 * j]; xr[64 * j] = v[j] * rs * g; }
}
__device__ __forceinline__ void transpose_item(const float* W, int K, int N, bf16* WT, int k0, int n0, int dst_row0, LAS float* scr, int lane) {
    const int rsub = lane >> 4, c4 = (lane & 15) * 4;
    f32x4 tv[16];
#pragma unroll
    for (int i = 0; i < 16; ++i) tv[i] = *(const f32x4*)(W + (size_t)(k0 + 4 * i + rsub) * N + n0 + c4);
#pragma unroll
    for (int i = 0; i < 16; ++i) { LAS float* d = scr + (4 * i + rsub) * 65 + c4; d[0] = tv[i].x; d[1] = tv[i].y; d[2] = tv[i].z; d[3] = tv[i].w; }
    LDS_WAIT(); asm volatile("" ::: "memory");
    const int c = lane & 7;
#pragma unroll
    for (int j = 0; j < 8; ++j) { const int n = (lane >> 3) + 8 * j; const LAS float* s = scr + (8 * c) * 65 + n;
        u32x4 o; o.x = cvt_pk_bf16(s[0 * 65], s[1 * 65]); o.y = cvt_pk_bf16(s[2 * 65], s[3 * 65]); o.z = cvt_pk_bf16(s[4 * 65], s[5 * 65]); o.w = cvt_pk_bf16(s[6 * 65], s[7 * 65]);
        *(u32x4*)(WT + (size_t)(dst_row0 + n) * K + k0 + 8 * c) = o; }
    LDS_WAIT(); asm volatile("" ::: "memory");
}
__device__ __forceinline__ void convert_item(const float* src, bf16* dst, size_t item, int lane) {
    const f32x4* s = (const f32x4*)(src + item * 2048) + lane * 2; u32x4* d = (u32x4*)(dst + item * 2048) + lane;
#pragma unroll
    for (int j = 0; j < 4; ++j) { const f32x4 a = s[128 * j], b = s[128 * j + 1]; u32x4 o; o.x = cvt_pk_bf16(a.x, a.y); o.y = cvt_pk_bf16(a.z, a.w); o.z = cvt_pk_bf16(b.x, b.y); o.w = cvt_pk_bf16(b.z, b.w); d[64 * j] = o; }
}
__device__ __forceinline__ void convert_item8(const float* src, unsigned char* dst, size_t item, int lane, float scale, const float* colgain) {
    const f32x4* s = (const f32x4*)(src + item * 2048) + lane * 4; u32x4* d = (u32x4*)(dst + item * 2048) + lane;
    const f32x4* cg = colgain ? (const f32x4*)(colgain + (item & 1) * 2048) + lane * 4 : nullptr;
#pragma unroll
    for (int j = 0; j < 2; ++j) { f32x4 a = s[256 * j] * scale, b = s[256 * j + 1] * scale, c = s[256 * j + 2] * scale, e = s[256 * j + 3] * scale;
        if (cg) { a = a * cg[256 * j]; b = b * cg[256 * j + 1]; c = c * cg[256 * j + 2]; e = e * cg[256 * j + 3]; }
        u32x4 o; o.x = pk4_fp8(a.x, a.y, a.z, a.w); o.y = pk4_fp8(b.x, b.y, b.z, b.w); o.z = pk4_fp8(c.x, c.y, c.z, c.w); o.w = pk4_fp8(e.x, e.y, e.z, e.w); d[64 * j] = o; }
}
__device__ __forceinline__ void transpose_item8(const float* W, int K, int N, unsigned char* WT, int k0, int n0, int dst_row0, LAS float* scr, int lane, float scale) {
    const int rsub = lane >> 4, c4 = (lane & 15) * 4;
    f32x4 tv[16];
#pragma unroll
    for (int i = 0; i < 16; ++i) tv[i] = *(const f32x4*)(W + (size_t)(k0 + 4 * i + rsub) * N + n0 + c4);
#pragma unroll
    for (int i = 0; i < 16; ++i) { const f32x4 v = tv[i] * scale; LAS float* d = scr + (4 * i + rsub) * 65 + c4; d[0] = v.x; d[1] = v.y; d[2] = v.z; d[3] = v.w; }
    LDS_WAIT(); asm volatile("" ::: "memory");
    const int c = lane & 3;
#pragma unroll
    for (int j = 0; j < 4; ++j) { const int n = (lane >> 2) + 16 * j; const LAS float* s = scr + (16 * c) * 65 + n;
        u32x4 o; o.x = pk4_fp8(s[0 * 65], s[1 * 65], s[2 * 65], s[3 * 65]); o.y = pk4_fp8(s[4 * 65], s[5 * 65], s[6 * 65], s[7 * 65]);
        o.z = pk4_fp8(s[8 * 65], s[9 * 65], s[10 * 65], s[11 * 65]); o.w = pk4_fp8(s[12 * 65], s[13 * 65], s[14 * 65], s[15 * 65]);
        *(u32x4*)(WT + (size_t)(dst_row0 + n) * K + k0 + 16 * c) = o; }
    LDS_WAIT(); asm volatile("" ::: "memory");
}
__device__ __forceinline__ void transpose_item8b(const float* W, int K, int N, unsigned char* WT, int k0, int n0, int dst_row0, LAS float* scr, int lane, float scale) {
    const int rsub = lane >> 3, c4 = (lane & 7) * 4;
    f32x4 tv[16];
#pragma unroll
    for (int i = 0; i < 16; ++i) tv[i] = *(const f32x4*)(W + (size_t)(k0 + 8 * i + rsub) * N + n0 + c4);
#pragma unroll
    for (int i = 0; i < 16; ++i) { const f32x4 v = tv[i] * scale; LAS float* d = scr + (8 * i + rsub) * 33 + c4; d[0] = v.x; d[1] = v.y; d[2] = v.z; d[3] = v.w; }
    LDS_WAIT(); asm volatile("" ::: "memory");
#pragma unroll
    for (int jn = 0; jn < 2; ++jn)
#pragma unroll
        for (int jc = 0; jc < 2; ++jc) { const int n = (lane & 15) + 16 * jn, c = (lane >> 4) + 4 * jc; const LAS float* sp = scr + (16 * c) * 33 + n;
            u32x4 o; o.x = pk4_fp8(sp[0 * 33], sp[1 * 33], sp[2 * 33], sp[3 * 33]); o.y = pk4_fp8(sp[4 * 33], sp[5 * 33], sp[6 * 33], sp[7 * 33]);
            o.z = pk4_fp8(sp[8 * 33], sp[9 * 33], sp[10 * 33], sp[11 * 33]); o.w = pk4_fp8(sp[12 * 33], sp[13 * 33], sp[14 * 33], sp[15 * 33]);
            *(u32x4*)(WT + (size_t)(dst_row0 + n) * K + k0 + 16 * c) = o; }
    LDS_WAIT(); asm volatile("" ::: "memory");
}
__device__ __forceinline__ void rms_row_fp8(const float* xrow, const float* w, unsigned char* o8row, int lane) {
    const f32x4* xr = (const f32x4*)xrow + lane; const f32x4* wr = (const f32x4*)w + lane;
    f32x4 v[16]; float ss = 0.f;
#pragma unroll
    for (int j = 0; j < 16; ++j) { v[j] = xr[64 * j]; ss += (v[j].x * v[j].x + v[j].y * v[j].y) + (v[j].z * v[j].z + v[j].w * v[j].w); }
    const float rs = 16.0f / sqrtf(wave_sum(ss) * (1.0f / D) + EPS);
    unsigned* q8 = (unsigned*)o8row + lane;
#pragma unroll
    for (int j = 0; j < 16; ++j) { const f32x4 g = wr[64 * j]; const f32x4 y = v[j] * rs * g; q8[64 * j] = pk4_fp8(y.x, y.y, y.z, y.w); }
}
__device__ __forceinline__ void rms_row_bf16_fp8(const float* xrow, const float* w, bf16* orow, unsigned char* o8row, int lane) {
    const f32x4* xr = (const f32x4*)xrow + lane; const f32x4* wr = (const f32x4*)w + lane;
    f32x4 v[16]; float ss = 0.f;
#pragma unroll
    for (int j = 0; j < 16; ++j) { v[j] = xr[64 * j]; ss += (v[j].x * v[j].x + v[j].y * v[j].y) + (v[j].z * v[j].z + v[j].w * v[j].w); }
    const float rs = 1.0f / sqrtf(wave_sum(ss) * (1.0f / D) + EPS);
    u32x2* o8 = (u32x2*)orow + lane; unsigned* q8 = (unsigned*)o8row + lane;
#pragma unroll
    for (int j = 0; j < 16; ++j) { const f32x4 g = wr[64 * j]; const f32x4 y = v[j] * rs * g; u32x2 o; o.x = cvt_pk_bf16(y.x, y.y); o.y = cvt_pk_bf16(y.z, y.w); o8[64 * j] = o;
        q8[64 * j] = pk4_fp8(16.f * y.x, 16.f * y.y, 16.f * y.z, 16.f * y.w); }
}
__device__ __forceinline__ void rms_rows_bf16_fp8(const float* x, const LAS float* gl, bf16* xn, unsigned char* x8, int gw, int ngw, int nrows, int lane) {
    if (gw >= nrows) return;
    f32x4 cur[16], nxt[16];
    { const f32x4* xr = (const f32x4*)(x + (size_t)gw * D) + lane;
#pragma unroll
      for (int j = 0; j < 16; ++j) cur[j] = xr[64 * j]; }
    const LAS f32x4* g4 = (const LAS f32x4*)gl + lane;
    for (int m = gw; m < nrows; m += ngw) {
        const bool more = m + ngw < nrows;
        if (more) { const f32x4* xr = (const f32x4*)(x + (size_t)(m + ngw) * D) + lane;
#pragma unroll
            for (int j = 0; j < 16; ++j) nxt[j] = xr[64 * j]; }
        __builtin_amdgcn_sched_barrier(0);
        float ss = 0.f;
#pragma unroll
        for (int j = 0; j < 16; ++j) ss += (cur[j].x * cur[j].x + cur[j].y * cur[j].y) + (cur[j].z * cur[j].z + cur[j].w * cur[j].w);
        const float rs = 1.0f / sqrtf(wave_sum(ss) * (1.0f / D) + EPS);
        u32x2* o8 = (u32x2*)(xn + (size_t)m * D) + lane; unsigned* q8 = (unsigned*)(x8 + (size_t)m * D) + lane;
#pragma unroll
        for (int j = 0; j < 16; ++j) { const f32x4 y = cur[j] * rs * g4[64 * j]; u32x2 o; o.x = cvt_pk_bf16(y.x, y.y); o.y = cvt_pk_bf16(y.z, y.w); o8[64 * j] = o;
            q8[64 * j] = pk4_fp8(16.f * y.x, 16.f * y.y, 16.f * y.z, 16.f * y.w); }
        __builtin_amdgcn_sched_barrier(0);
        if (more) {
#pragma unroll
            for (int j = 0; j < 16; ++j) cur[j] = nxt[j]; }
    }
}
__device__ __forceinline__ void rms_rows_bf16_to_f32(const bf16* h, const LAS float* gl, float* out, int gw, int ngw, int nrows, int lane) {
    if (gw >= nrows) return;
    u32x4 cur[8], nxt[8];
    { const u32x4* hr = (const u32x4*)(h + (size_t)gw * D) + lane;
#pragma unroll
      for (int j = 0; j < 8; ++j) cur[j] = hr[64 * j]; }
    const LAS f32x4* g4 = (const LAS f32x4*)gl + lane * 2;
    for (int m = gw; m < nrows; m += ngw) {
        const bool more = m + ngw < nrows;
        if (more) { const u32x4* hr = (const u32x4*)(h + (size_t)(m + ngw) * D) + lane;
#pragma unroll
            for (int j = 0; j < 8; ++j) nxt[j] = hr[64 * j]; }
        __builtin_amdgcn_sched_barrier(0);
        float ss = 0.f;
#pragma unroll
        for (int j = 0; j < 8; ++j)
#pragma unroll
            for (int e = 0; e < 4; ++e) { const float a = bf_lo(cur[j][e]), b = bf_hi(cur[j][e]); ss += a * a + b * b; }
        const float rs = 1.0f / sqrtf(wave_sum(ss) * (1.0f / D) + EPS);
        f32x4* o4 = (f32x4*)(out + (size_t)m * D) + lane * 2;
#pragma unroll
        for (int j = 0; j < 8; ++j) { const f32x4 g0 = g4[128 * j], g1 = g4[128 * j + 1];
            o4[128 * j] = (f32x4){bf_lo(cur[j].x), bf_hi(cur[j].x), bf_lo(cur[j].y), bf_hi(cur[j].y)} * rs * g0;
            o4[128 * j + 1] = (f32x4){bf_lo(cur[j].z), bf_hi(cur[j].z), bf_lo(cur[j].w), bf_hi(cur[j].w)} * rs * g1; }
        __builtin_amdgcn_sched_barrier(0);
        if (more) {
#pragma unroll
            for (int j = 0; j < 8; ++j) cur[j] = nxt[j]; }
    }
}
__device__ __forceinline__ bf16x8 ld8_f32_bf16(const float* p) { const f32x4 a = *(const f32x4*)p, b = *(const f32x4*)(p + 4); u32x4 o; o.x = cvt_pk_bf16(a.x, a.y); o.y = cvt_pk_bf16(a.z, a.w); o.z = cvt_pk_bf16(b.x, b.y); o.w = cvt_pk_bf16(b.z, b.w); return __builtin_bit_cast(bf16x8, o); }
__device__ __forceinline__ bf16x8 cvt8_bf16(const f32x4 a, const f32x4 b) { u32x4 o; o.x = cvt_pk_bf16(a.x, a.y); o.y = cvt_pk_bf16(a.z, a.w); o.z = cvt_pk_bf16(b.x, b.y); o.w = cvt_pk_bf16(b.z, b.w); return __builtin_bit_cast(bf16x8, o); }
__device__ __forceinline__ void wpp_item(const float* wq, const float* sk, const float* cgain, bf16* WppT, int item, int lane) {
    const int hp = item >> 8, c0 = (item & 255) * 16, fr = lane & 15, fq = lane >> 4;
    f32x4 araw[4][2];
#pragma unroll
    for (int ds = 0; ds < 4; ++ds) { const float* pa = wq + (size_t)(c0 + fr) * 2048 + hp * 128 + 32 * ds + 8 * fq; araw[ds][0] = *(const f32x4*)pa; araw[ds][1] = *(const f32x4*)(pa + 4); }
    const f32x4 cg = *(const f32x4*)(cgain + c0 + 4 * fq);
    bf16x8 af[4];
#pragma unroll
    for (int h2 = 0; h2 < 2; ++h2) {
        f32x4 braw[4][4][2];
#pragma unroll
        for (int k4 = 0; k4 < 4; ++k4)
#pragma unroll
            for (int ds = 0; ds < 4; ++ds) { const float* pb = sk + ((size_t)hp * 128 + 16 * (4 * h2 + k4) + fr) * 128 + 32 * ds + 8 * fq; braw[k4][ds][0] = *(const f32x4*)pb; braw[k4][ds][1] = *(const f32x4*)(pb + 4); }
        __builtin_amdgcn_sched_barrier(0);
        if (h2 == 0) {
#pragma unroll
            for (int ds = 0; ds < 4; ++ds) af[ds] = cvt8_bf16(araw[ds][0], araw[ds][1]); }
#pragma unroll
        for (int k4 = 0; k4 < 4; ++k4) { const int kt = 4 * h2 + k4;
            f32x4 acc = (f32x4){0.f, 0.f, 0.f, 0.f};
#pragma unroll
            for (int ds = 0; ds < 4; ++ds) acc = __builtin_amdgcn_mfma_f32_16x16x32_bf16(af[ds], cvt8_bf16(braw[k4][ds][0], braw[k4][ds][1]), acc, 0, 0, 0);
            acc = acc * cg;
            u32x2 o; o.x = cvt_pk_bf16(acc[0], acc[1]); o.y = cvt_pk_bf16(acc[2], acc[3]);
            *(u32x2*)(WppT + (size_t)(hp * 128 + 16 * kt + fr) * 4096 + c0 + 4 * fq) = o; }
        __builtin_amdgcn_sched_barrier(0);
    }
}

constexpr int ATT_K0 = 0, ATT_KB = 16384, ATT_V0 = 32768, ATT_VB = 40960, ATT_VROW = 160;
static_assert(ATT_V0 + 2 * ATT_VB <= RING_BYTES, "attention LDS");

__device__ __forceinline__ void attn_unit(LAS unsigned char* lds, const bf16* __restrict__ qkvn, const bf16* __restrict__ kT, const bf16* __restrict__ vT, unsigned char* __restrict__ mix, const float* __restrict__ rel_bias,
                                          int b, int h, int qb, int tid, int wid, int lane) {
    asm volatile("" : "+v"(tid), "+v"(lane), "+s"(wid));
    const int fr = lane & 15, fq = lane >> 4;
    LAS float* biasl = (LAS float*)(lds + XCH_OFF);
    __syncthreads();
    for (int i = tid; i < 832; i += 512) biasl[i] = rel_bias[h * 513 + (i < 512 ? i : 512)] * LOG2E;
    const int t0 = b * SEQ + qb * 256;
    const int nw = qb * 4 + (wid >> 1);
    const int m_lo = (qb * 4 - 8) > 0 ? (qb * 4 - 8) : 0, m_hi = qb * 4 + 3;
    bf16x8 qf[2][4];
#pragma unroll
    for (int qt = 0; qt < 2; ++qt)
#pragma unroll
        for (int ks = 0; ks < 4; ++ks) qf[qt][ks] = *(const bf16x8*)(qkvn + (size_t)(t0 + 32 * wid + 16 * qt + fr) * 8192 + h * 128 + 32 * ks + 8 * fq);
    f32x4 oacc[8][2];
#pragma unroll
    for (int dt = 0; dt < 8; ++dt) { oacc[dt][0] = (f32x4){0.f, 0.f, 0.f, 0.f}; oacc[dt][1] = (f32x4){0.f, 0.f, 0.f, 0.f}; }
    float mrow[2] = {-1.0e30f, -1.0e30f}, lrow[2] = {0.f, 0.f};
    u32x4 kr[2], vr[2];
    const bf16* kbase = kT + (size_t)(b * 16 + h) * 32 * 8192;
    const bf16* vbase = vT + (size_t)(b * 16 + h) * 32 * 8192;
#define ATT_LOAD(m) do { _Pragma("unroll") for (int i = 0; i < 2; ++i) { const int id = tid + 512 * i; \
        kr[i] = *(const u32x4*)(kbase + (size_t)(m) * 8192 + id * 8); \
        vr[i] = *(const u32x4*)(vbase + (size_t)(m) * 8192 + id * 8); } } while (0)
#define ATT_WRITE(buf) do { _Pragma("unroll") for (int i = 0; i < 2; ++i) { const int id = tid + 512 * i; const int kr_ = id >> 4, kc_ = id & 15; \
        *(LAS u32x4*)(lds + ATT_K0 + (buf) * ATT_KB + kr_ * 256 + ((kc_ ^ (kr_ & 15)) << 4)) = kr[i]; \
        *(LAS u32x4*)(lds + ATT_V0 + (buf) * ATT_VB + (id >> 3) * ATT_VROW + (id & 7) * 16) = vr[i]; } } while (0)
    ATT_LOAD(m_lo); ATT_WRITE(0);
    __syncthreads();
    const float SCALE = 0.08838834764831845f * LOG2E;
    for (int m = m_lo; m <= m_hi; ++m) {
        const int cur = (m - m_lo) & 1;
        if (m < m_hi) ATT_LOAD(m + 1);
        if (m >= nw - 8 && m <= nw) {
            const LAS unsigned char* Kb = lds + ATT_K0 + cur * ATT_KB; const LAS unsigned char* Vb = lds + ATT_V0 + cur * ATT_VB;
            f32x4 sacc[4][2];
#pragma unroll
            for (int kt = 0; kt < 4; ++kt) { sacc[kt][0] = (f32x4){0.f, 0.f, 0.f, 0.f}; sacc[kt][1] = (f32x4){0.f, 0.f, 0.f, 0.f}; }
            __builtin_amdgcn_s_setprio(1);
#pragma unroll
            for (int ks = 0; ks < 4; ++ks)
#pragma unroll
                for (int kt = 0; kt < 4; ++kt) { const bf16x8 kf = *(const LAS bf16x8*)(Kb + (16 * kt + fr) * 256 + (((4 * ks + fq) ^ fr) << 4));
                    sacc[kt][0] = __builtin_amdgcn_mfma_f32_16x16x32_bf16(kf, qf[0][ks], sacc[kt][0], 0, 0, 0);
                    sacc[kt][1] = __builtin_amdgcn_mfma_f32_16x16x32_bf16(kf, qf[1][ks], sacc[kt][1], 0, 0, 0);
                    if (kt == 3) __builtin_amdgcn_sched_barrier(0); }
            __builtin_amdgcn_s_setprio(0);
            const int dc = nw - m;
            bf16x8 pf[2][2];
#pragma unroll
            for (int qt = 0; qt < 2; ++qt) {
                const int qi = 32 * (wid & 1) + 16 * qt + fr;
                float mx = -3.0e38f;
                const LAS float* bp = biasl + (64 * dc + qi + 256 - 4 * fq - 63);
#pragma unroll
                for (int kt = 0; kt < 4; ++kt)
#pragma unroll
                    for (int r = 0; r < 4; ++r) { const float v = sacc[kt][qt][r] * SCALE + bp[63 - 16 * kt - r]; sacc[kt][qt][r] = v; mx = fmaxf(mx, v); }
                mx = fmaxf(mx, __shfl_xor(mx, 16)); mx = fmaxf(mx, __shfl_xor(mx, 32));
                if (__any(mx > mrow[qt] + 8.0f)) {
                    const float mnew = fmaxf(mrow[qt], mx), alpha = __builtin_amdgcn_exp2f(mrow[qt] - mnew);
                    mrow[qt] = mnew; lrow[qt] = lrow[qt] * alpha;
#pragma unroll
                    for (int dt = 0; dt < 8; ++dt) oacc[dt][qt] = oacc[dt][qt] * alpha;
                }
                const float mcur = mrow[qt];
                float ls = 0.f;
#pragma unroll
                for (int kt = 0; kt < 4; ++kt)
#pragma unroll
                    for (int r = 0; r < 4; ++r) { const float p = __builtin_amdgcn_exp2f(sacc[kt][qt][r] - mcur); sacc[kt][qt][r] = p; ls += p; }
                lrow[qt] += ls;
#pragma unroll
                for (int s = 0; s < 2; ++s) { u32x4 w; w.x = cvt_pk_bf16(sacc[2 * s][qt][0], sacc[2 * s][qt][1]); w.y = cvt_pk_bf16(sacc[2 * s][qt][2], sacc[2 * s][qt][3]);
                    w.z = cvt_pk_bf16(sacc[2 * s + 1][qt][0], sacc[2 * s + 1][qt][1]); w.w = cvt_pk_bf16(sacc[2 * s + 1][qt][2], sacc[2 * s + 1][qt][3]); pf[qt][s] = __builtin_bit_cast(bf16x8, w); }
                __builtin_amdgcn_sched_barrier(0);
            }
            __builtin_amdgcn_s_setprio(1);
#pragma unroll
            for (int dt = 0; dt < 8; ++dt)
#pragma unroll
                for (int s = 0; s < 2; ++s) { const bf16x8 vf = *(const LAS bf16x8*)(Vb + (16 * dt + fr) * ATT_VROW + 64 * s + 16 * fq);
                    oacc[dt][0] = __builtin_amdgcn_mfma_f32_16x16x32_bf16(vf, pf[0][s], oacc[dt][0], 0, 0, 0);
                    oacc[dt][1] = __builtin_amdgcn_mfma_f32_16x16x32_bf16(vf, pf[1][s], oacc[dt][1], 0, 0, 0);
                    if ((dt & 3) == 3 && s == 1) __builtin_amdgcn_sched_barrier(0); }
            __builtin_amdgcn_s_setprio(0);
        }
        if (m < m_hi) ATT_WRITE(cur ^ 1);
        __syncthreads();
    }
#undef ATT_LOAD
#undef ATT_WRITE
#pragma unroll
    for (int qt = 0; qt < 2; ++qt) {
        float l = lrow[qt]; l += __shfl_xor(l, 16); l += __shfl_xor(l, 32);
        const float inv = 1.0f / l;
        unsigned char* orow = mix + (size_t)(t0 + 32 * wid + 16 * qt + fr) * 4096 + h * 128 + 4 * fq;
        const float inv128 = 128.0f * inv;
#pragma unroll
        for (int dt = 0; dt < 8; ++dt) { const f32x4 o = oacc[dt][qt] * inv128; *(unsigned*)(orow + 16 * dt) = pk4_fp8(o[0], o[1], o[2], o[3]); }
    }
}

__device__ __forceinline__ void ret_unit(LAS unsigned char* lds, const bf16* __restrict__ qkvn, const bf16* __restrict__ kT, const bf16* __restrict__ vT, unsigned char* __restrict__ mix, const float* __restrict__ gn_w,
                                         int b, int h, int qb2, int tid, int wid, int lane) {
    asm volatile("" : "+v"(tid), "+v"(lane), "+s"(wid));
    const int fr = lane & 15, fq = lane >> 4;
    __syncthreads();
    const int t0 = b * SEQ + qb2 * 128;
    const int nw = qb2 * 2 + (wid >> 2);
    const int m_hi = qb2 * 2 + 1;
    float lg2g; { const float x = __builtin_amdgcn_exp2f((float)(-5 - h)); lg2g = -(x * (1.0f + x * (0.5f + x * (0.33333334f + x * (0.25f + x * (0.2f + x * 0.16666667f)))))) * LOG2E; }
    bf16x8 qf[4];
#pragma unroll
    for (int ks = 0; ks < 4; ++ks) qf[ks] = *(const bf16x8*)(qkvn + (size_t)(t0 + 16 * wid + fr) * 8192 + 4096 + h * 128 + 32 * ks + 8 * fq);
    f32x4 oacc[16];
#pragma unroll
    for (int dt = 0; dt < 16; ++dt) oacc[dt] = (f32x4){0.f, 0.f, 0.f, 0.f};
    u32x4 kr[2], vr[4];
    const bf16* kbase = kT + (size_t)(b * 8 + h) * 32 * 8192;
    const bf16* vbase = vT + (size_t)(b * 8 + h) * 32 * 16384;
#define RET_LOAD(m) do { _Pragma("unroll") for (int i = 0; i < 2; ++i) { const int id = tid + 512 * i; kr[i] = *(const u32x4*)(kbase + (size_t)(m) * 8192 + id * 8); } \
        _Pragma("unroll") for (int i = 0; i < 4; ++i) { const int id = tid + 512 * i; vr[i] = *(const u32x4*)(vbase + (size_t)(m) * 16384 + id * 8); } } while (0)
#define RET_W1(buf, i) do { if ((i) < 2) *(LAS u32x4*)(lds + ATT_K0 + (buf) * ATT_KB + kw0 + (i) * 8192) = kr[(i) & 1];        \
        else *(LAS u32x4*)(lds + ATT_V0 + (buf) * ATT_VB + vw0 + ((i) - 2) * 64 * ATT_VROW) = vr[((i) - 2) & 3]; } while (0)
#define RET_WRITE(buf) do { RET_W1(buf, 0); RET_W1(buf, 1); RET_W1(buf, 2); RET_W1(buf, 3); RET_W1(buf, 4); RET_W1(buf, 5); } while (0)
#define RET_BAR() do { asm volatile("s_waitcnt lgkmcnt(0)" ::: "memory"); __builtin_amdgcn_s_barrier(); asm volatile("" ::: "memory"); } while (0)
    const int kw0 = (tid >> 4) * 256 + (((tid & 15) ^ ((tid >> 4) & 15)) << 4), vw0 = (tid >> 3) * ATT_VROW + (tid & 7) * 16;
    RET_LOAD(0); RET_WRITE(0); RET_LOAD(1);
    RET_BAR();
    const int qi = 16 * (wid & 3) + fr;
    const float rowf = 0.08838834764831845f * __builtin_amdgcn_exp2f(lg2g * (float)qi);
    float colr[4], colk[4];
#pragma unroll
    for (int r = 0; r < 4; ++r) { colr[r] = __builtin_amdgcn_exp2f(-lg2g * (float)(4 * fq + r));
        colk[r] = __builtin_bit_cast(float, __builtin_amdgcn_readfirstlane(__builtin_bit_cast(int, __builtin_amdgcn_exp2f(-lg2g * (float)(16 * r))))); }
#define RET_SB() __builtin_amdgcn_sched_barrier(0)
#define RET_LDK(F, ks) do { _Pragma("unroll") for (int kt = 0; kt < 4; ++kt) F[kt] = *(const LAS bf16x8*)(Kb + (16 * kt + fr) * 256 + (((4 * (ks) + fq) ^ fr) << 4)); } while (0)
#define RET_LDV(F, g) do { _Pragma("unroll") for (int e = 0; e < 4; ++e) F[e] = *(const LAS bf16x8*)(Vb + (16 * (2 * (g) + (e >> 1)) + fr) * ATT_VROW + 64 * (e & 1) + 16 * fq); } while (0)
#define RET_MMK(F, ks) do { _Pragma("unroll") for (int kt = 0; kt < 4; ++kt) sacc[kt] = __builtin_amdgcn_mfma_f32_16x16x32_bf16(F[kt], qf[ks], sacc[kt], 0, 0, 0); } while (0)
#define RET_MMV(F, g) do { _Pragma("unroll") for (int e = 0; e < 4; ++e) oacc[2 * (g) + (e >> 1)] = __builtin_amdgcn_mfma_f32_16x16x32_bf16(F[e], pf[e & 1], oacc[2 * (g) + (e >> 1)], 0, 0, 0); } while (0)
#define RET_COMPUTE(mm, buf, ml) do { const int m_ = (mm); if (m_ <= nw) { \
            const LAS unsigned char* Kb = lds + ATT_K0 + (m_ & 1) * ATT_KB; const LAS unsigned char* Vb = lds + ATT_V0 + (m_ & 1) * ATT_VB; \
            f32x4 sacc[4]; bf16x8 fa[4], fb[4]; \
            _Pragma("unroll") for (int kt = 0; kt < 4; ++kt) sacc[kt] = (f32x4){0.f, 0.f, 0.f, 0.f}; \
            RET_LDK(fa, 0); RET_SB(); \
            RET_LDK(fb, 1); RET_SB(); RET_MMK(fa, 0); RET_SB(); \
            RET_LDK(fa, 2); RET_SB(); RET_MMK(fb, 1); RET_SB(); \
            RET_LDK(fb, 3); RET_SB(); RET_MMK(fa, 2); RET_SB(); \
            RET_LDV(fa, 0); RET_SB(); RET_MMK(fb, 3); RET_SB(); \
            RET_LDV(fb, 1); RET_SB(); \
            if (m_ < nw) { const float rs_ = rowf * __builtin_amdgcn_exp2f(lg2g * (float)(64 * (nw - m_))); \
                _Pragma("unroll") for (int kt = 0; kt < 4; ++kt) { const float rk_ = rs_ * colk[kt]; _Pragma("unroll") for (int r = 0; r < 4; ++r) sacc[kt][r] = sacc[kt][r] * (rk_ * colr[r]); } \
            } else { \
                _Pragma("unroll") for (int kt = 0; kt < 4; ++kt) _Pragma("unroll") for (int r = 0; r < 4; ++r) { int dist = qi - (16 * kt + 4 * fq + r); dist = dist < 0 ? -dist : dist; \
                        sacc[kt][r] = sacc[kt][r] * (0.08838834764831845f * __builtin_amdgcn_exp2f(lg2g * (float)dist)); } } \
            bf16x8 pf[2]; \
            _Pragma("unroll") for (int s = 0; s < 2; ++s) { u32x4 w; w.x = cvt_pk_bf16(sacc[2 * s][0], sacc[2 * s][1]); w.y = cvt_pk_bf16(sacc[2 * s][2], sacc[2 * s][3]); \
                w.z = cvt_pk_bf16(sacc[2 * s + 1][0], sacc[2 * s + 1][1]); w.w = cvt_pk_bf16(sacc[2 * s + 1][2], sacc[2 * s + 1][3]); pf[s] = __builtin_bit_cast(bf16x8, w); } \
            RET_SB(); \
            RET_MMV(fa, 0); RET_SB(); RET_LDV(fa, 2); RET_SB(); \
            RET_MMV(fb, 1); RET_SB(); RET_LDV(fb, 3); RET_W1(buf, 0); RET_SB(); \
            RET_MMV(fa, 2); RET_SB(); RET_LDV(fa, 4); RET_W1(buf, 1); RET_SB(); \
            RET_MMV(fb, 3); RET_SB(); RET_LDV(fb, 5); RET_W1(buf, 2); RET_SB(); \
            RET_MMV(fa, 4); RET_SB(); RET_LDV(fa, 6); RET_W1(buf, 3); RET_SB(); \
            RET_MMV(fb, 5); RET_SB(); RET_LDV(fb, 7); RET_W1(buf, 4); RET_SB(); \
            RET_MMV(fa, 6); RET_SB(); RET_W1(buf, 5); RET_SB(); RET_MMV(fb, 7); RET_SB(); \
        } else { RET_WRITE(buf); } RET_LOAD(ml); } while (0)
    for (int m = 0; m <= m_hi; m += 2) {
        { const int ml = m + 2 <= m_hi ? m + 2 : m_hi; RET_COMPUTE(m, 1, ml); }
        RET_BAR();
        { const int ml = m + 3 <= m_hi ? m + 3 : m_hi; RET_COMPUTE(m + 1, 0, ml); }
        RET_BAR();
    }
#undef RET_LOAD
#undef RET_WRITE
#undef RET_COMPUTE
#undef RET_W1
#undef RET_SB
#undef RET_LDK
#undef RET_LDV
#undef RET_MMK
#undef RET_MMV
#undef RET_BAR
    float s1 = 0.f;
#pragma unroll
    for (int dt = 0; dt < 16; ++dt) s1 += (oacc[dt][0] + oacc[dt][1]) + (oacc[dt][2] + oacc[dt][3]);
    s1 += __shfl_xor(s1, 16); s1 += __shfl_xor(s1, 32);
    const float mu = s1 * (1.0f / 256.0f);
    float s2 = 0.f;
#pragma unroll
    for (int dt = 0; dt < 16; ++dt) { const f32x4 d = oacc[dt] - mu; s2 += (d[0] * d[0] + d[1] * d[1]) + (d[2] * d[2] + d[3] * d[3]); }
    s2 += __shfl_xor(s2, 16); s2 += __shfl_xor(s2, 32);
    const float rstd = 1.0f / sqrtf(s2 * (1.0f / 256.0f) + EPS);
    const size_t trow = (size_t)(t0 + 16 * wid + fr);
    const bf16* grow = qkvn + trow * 8192 + 6144 + h * 256 + 4 * fq;
    unsigned char* orow = mix + trow * 4096 + 2048 + h * 256 + 4 * fq;
    const float* gw = gn_w + h * 256 + 4 * fq;
#pragma unroll
    for (int dt = 0; dt < 16; ++dt) {
        const u32x2 gg = *(const u32x2*)(grow + 16 * dt); const f32x4 w = *(const f32x4*)(gw + 16 * dt);
        const float g0 = bf_lo(gg.x), g1 = bf_hi(gg.x), g2 = bf_lo(gg.y), g3 = bf_hi(gg.y);
        const f32x4 yn = (oacc[dt] - mu) * rstd * w;
        const float o0 = yn[0] * g0 / (1.0f + __builtin_amdgcn_exp2f(-g0 * LOG2E)), o1 = yn[1] * g1 / (1.0f + __builtin_amdgcn_exp2f(-g1 * LOG2E));
        const float o2 = yn[2] * g2 / (1.0f + __builtin_amdgcn_exp2f(-g2 * LOG2E)), o3 = yn[3] * g3 / (1.0f + __builtin_amdgcn_exp2f(-g3 * LOG2E));
        *(unsigned*)(orow + 16 * dt) = pk4_fp8(16.f * o0, 16.f * o1, 16.f * o2, 16.f * o3);
        if ((dt & 3) == 3) asm volatile("" ::: "memory");
    }
}

__device__ __forceinline__ unsigned key_pack(float v, int k) { unsigned u = __builtin_bit_cast(unsigned, v); u = (u & 0x80000000u) ? ~u : (u | 0x80000000u); return (u & ~127u) | (unsigned)(127 - k); }
__device__ __forceinline__ float key_val(unsigned p) { unsigned u = p & ~127u; u = (u & 0x80000000u) ? (u & 0x7fffffffu) : ~u; return __builtin_bit_cast(float, u); }
__device__ __forceinline__ float rdl_f(float v, int l) { return __builtin_bit_cast(float, __builtin_amdgcn_readlane(__builtin_bit_cast(int, v), l)); }

template <int CTRL> __device__ __forceinline__ unsigned dpp_u(unsigned v) { return (unsigned)__builtin_amdgcn_update_dpp((int)v, (int)v, CTRL, 0xf, 0xf, false); }
__device__ __forceinline__ unsigned row_max_u(unsigned v) { unsigned t;
    t = dpp_u<0xB1>(v); v = t > v ? t : v; t = dpp_u<0x4E>(v); v = t > v ? t : v; t = dpp_u<0x141>(v); v = t > v ? t : v; t = dpp_u<0x140>(v); v = t > v ? t : v; return v; }
__device__ __forceinline__ float row_sum_f(float v) {
    v += __builtin_bit_cast(float, dpp_u<0xB1>(__builtin_bit_cast(unsigned, v))); v += __builtin_bit_cast(float, dpp_u<0x4E>(__builtin_bit_cast(unsigned, v)));
    v += __builtin_bit_cast(float, dpp_u<0x141>(__builtin_bit_cast(unsigned, v))); v += __builtin_bit_cast(float, dpp_u<0x140>(__builtin_bit_cast(unsigned, v))); return v; }
#define TK_CE(a, b) do { const unsigned hi_ = (a) > (b) ? (a) : (b), lo_ = (a) > (b) ? (b) : (a); (a) = hi_; (b) = lo_; } while (0)
__device__ __forceinline__ unsigned ord_u(float v) { const unsigned u = __builtin_bit_cast(unsigned, v); return (u & 0x80000000u) ? ~u : (u | 0x80000000u); }
__device__ __forceinline__ float ord_f(unsigned u) { return __builtin_bit_cast(float, (u & 0x80000000u) ? (u & 0x7fffffffu) : ~u); }

__device__ __forceinline__ void topk_phase(LAS unsigned char* lds, const float* __restrict__ scores, unsigned char* __restrict__ G, int gw, int ngw, int wid, int lane) {
    LAS unsigned* bm = (LAS unsigned*)(lds + wid * 2048);
    LAS unsigned char* lut = (LAS unsigned char*)(lds + 16384 + wid * 64);
#pragma unroll
    for (int i = 0; i < 8; ++i) bm[lane + 64 * i] = 0u;
    { int ci = 0, cj = 0, cnt = 0;
#pragma unroll
      for (int i = 0; i < 16; ++i) { const int n = 16 / (i + 1); if (lane >= cnt && lane < cnt + n) { ci = i; cj = lane - cnt; } cnt += n; }
      lut[lane] = (unsigned char)((ci << 4) | cj); }
    LDS_WAIT();
    const int l = lane & 15, rowbase = lane & 48; const bool oddrow = (lane & 16) != 0;
    int ic[4], jc[4];
#pragma unroll
    for (int sidx = 0; sidx < 4; ++sidx) { const int c = 4 * l + sidx; const unsigned ij = lut[c < 50 ? c : 0]; ic[sidx] = rowbase + (int)(ij >> 4); jc[sidx] = rowbase + (int)(ij & 15u); }
    for (int t = gw; t < T; t += ngw) {
        unsigned char* Grow = G + (size_t)t * NEXP;
        unsigned res[4];
        {
            unsigned k[4][8];
            const f32x4* sr = (const f32x4*)(scores + (size_t)t * 2048) + lane * 2;
#pragma unroll
            for (int p = 0; p < 4; ++p) { const f32x4 a = sr[p * 128], b = sr[p * 128 + 1];
#pragma unroll
                for (int e = 0; e < 4; ++e) { k[p][e] = (ord_u(a[e]) & ~127u) | (unsigned)(127 - (8 * l + e)); k[p][4 + e] = (ord_u(b[e]) & ~127u) | (unsigned)(127 - (8 * l + 4 + e)); }
                TK_CE(k[p][0], k[p][1]); TK_CE(k[p][2], k[p][3]); TK_CE(k[p][4], k[p][5]); TK_CE(k[p][6], k[p][7]);
                TK_CE(k[p][0], k[p][2]); TK_CE(k[p][1], k[p][3]); TK_CE(k[p][4], k[p][6]); TK_CE(k[p][5], k[p][7]);
                TK_CE(k[p][1], k[p][2]); TK_CE(k[p][5], k[p][6]);
                TK_CE(k[p][0], k[p][4]); TK_CE(k[p][1], k[p][5]); TK_CE(k[p][2], k[p][6]); TK_CE(k[p][3], k[p][7]);
                TK_CE(k[p][2], k[p][4]); TK_CE(k[p][3], k[p][5]);
                TK_CE(k[p][1], k[p][2]); TK_CE(k[p][3], k[p][4]); TK_CE(k[p][5], k[p][6]);
                res[p] = 0u; }
            for (int r = 0; r < 16; ++r) {
#pragma unroll
                for (int p = 0; p < 4; ++p) { const unsigned mm = row_max_u(k[p][0]); res[p] = (l == r) ? mm : res[p]; const bool pop = k[p][0] == mm;
#pragma unroll
                    for (int e = 0; e < 7; ++e) k[p][e] = pop ? k[p][e + 1] : k[p][e];
                    k[p][7] = pop ? 0u : k[p][7]; }
            }
        }
        int ee[2]; float gg[2]; bool dup[2];
#pragma unroll
        for (int q = 0; q < 2; ++q) {
            const unsigned tx = (unsigned)__shfl((int)res[2 * q + 1], lane - 16), ty = (unsigned)__shfl((int)res[2 * q], lane + 16);
            const unsigned X = oddrow ? tx : res[2 * q], Y = oddrow ? res[2 * q + 1] : ty;
            const float xv = ord_f(X & ~127u), yv = ord_f(Y & ~127u);
            unsigned ck[4];
#pragma unroll
            for (int sidx = 0; sidx < 4; ++sidx) { const float sum = __shfl(xv, ic[sidx]) + __shfl(yv, jc[sidx]); const int c = 4 * l + sidx;
                ck[sidx] = (c < 50) ? ((ord_u(sum) & ~63u) | (unsigned)(63 - c)) : 0u; }
            TK_CE(ck[0], ck[1]); TK_CE(ck[2], ck[3]); TK_CE(ck[0], ck[2]); TK_CE(ck[1], ck[3]); TK_CE(ck[1], ck[2]);
            unsigned win = 0u;
            for (int r = 0; r < 16; ++r) { const unsigned mm = row_max_u(ck[0]); win = (l == r) ? mm : win; const bool pop = ck[0] == mm;
                ck[0] = pop ? ck[1] : ck[0]; ck[1] = pop ? ck[2] : ck[1]; ck[2] = pop ? ck[3] : ck[2]; ck[3] = pop ? 0u : ck[3]; }
            const unsigned ij = lut[63 - (int)(win & 63u)];
            const int ia = 127 - (int)((unsigned)__shfl((int)X, rowbase + (int)(ij >> 4)) & 127u), ib = 127 - (int)((unsigned)__shfl((int)Y, rowbase + (int)(ij & 15u)) & 127u);
            const float val = ord_f(win & ~63u), vmax = __shfl(val, rowbase);
            const float ex = __builtin_amdgcn_exp2f((val - vmax) * LOG2E);
            gg[q] = ex / row_sum_f(ex); ee[q] = ia * 128 + ib; dup[q] = false;
        }
#pragma unroll
        for (int q = 0; q < 2; ++q) { const unsigned bit = 1u << (ee[q] & 31); const unsigned old = __hip_atomic_fetch_or(&bm[ee[q] >> 5], bit, __ATOMIC_RELAXED, __HIP_MEMORY_SCOPE_WORKGROUP); dup[q] = (old & bit) != 0u; }
#pragma unroll
        for (int q = 0; q < 2; ++q) { unsigned long long db = __ballot(dup[q]);
            while (db) { const int L = __builtin_ctzll(db); const int es = __builtin_amdgcn_readlane(ee[q], L); const float gs = rdl_f(gg[q], L);
#pragma unroll
                for (int q2 = 0; q2 < 2; ++q2) if (!dup[q2] && ee[q2] == es) gg[q2] += gs;
                db &= db - 1ull; } }
#pragma unroll
        for (int q = 0; q < 2; ++q) bm[ee[q] >> 5] = 0u;
#pragma unroll
        for (int q = 0; q < 2; ++q) if (!dup[q]) { const float qv = fminf(gg[q] * 128.0f + 0.5f, 255.0f); Grow[ee[q]] = (unsigned char)(unsigned)qv; }
    }
}
#undef TK_CE

struct Args { const float* in[18]; float* out; unsigned char* ws; int ph_lo, ph_hi, sub, pad; };
constexpr int NPHASE = 13;

__global__ void __launch_bounds__(NWAVES * 64, 2) fwd(Args args) {
    extern __shared__ __attribute__((aligned(16))) unsigned char lds_raw[];
    LAS unsigned char* lds = (LAS unsigned char*)lds_raw;
    volatile LAS unsigned* MISC = (volatile LAS unsigned*)(lds + MISC_OFF);
    const int tid = threadIdx.x, lane = tid & 63, wave = __builtin_amdgcn_readfirstlane(tid >> 6);
    const int G = gridDim.x, bx = blockIdx.x;
    const int vcu = (G % 8 == 0) ? (bx % 8) * (G / 8) + bx / 8 : bx;
    const int gw = vcu * NWAVES + wave, NGW = G * NWAVES;
    unsigned char* ws = args.ws;
    const float* x = args.in[0]; const float* mem = args.in[1]; const float* norm1_w = args.in[2]; const float* w_in = args.in[3]; const float* rel_bias = args.in[4];
    const float* gn_w = args.in[5]; const float* w_out = args.in[6]; const float* norm2_w = args.in[7]; const float* memn_w = args.in[8]; const float* xwq = args.in[9];
    const float* xwkv = args.in[10]; const float* xwo = args.in[11]; const float* norm3_w = args.in[12]; const float* pwq = args.in[13]; const float* psk = args.in[14];
    const float* pu = args.in[15]; const float* pv = args.in[16]; const float* fin_w = args.in[17];
    float* hout = args.out;
    bf16* W_IN = (bf16*)(ws + WS_WIN); bf16* W_OUT = (bf16*)(ws + WS_WOUT); bf16* W_Q = (bf16*)(ws + WS_WQ); bf16* W_KV = (bf16*)(ws + WS_WKV); bf16* W_O = (bf16*)(ws + WS_WO);
    bf16* W_PP = (bf16*)(ws + WS_WPP); bf16* W_U = (bf16*)(ws + WS_U); bf16* W_VT = (bf16*)(ws + WS_VT);
    bf16* XN = (bf16*)(ws + WS_XN); bf16* MEMN = (bf16*)(ws + WS_MEMN); bf16* KVM = (bf16*)(ws + WS_KVM); bf16* WP = (bf16*)(ws + WS_WP); bf16* VPT = (bf16*)(ws + WS_VPT);
    float* RP1 = (float*)(ws + 1 * MiB); float* RP2 = (float*)(ws + 1 * MiB + 512 * 1024);
    bf16* VT_A = (bf16*)(ws + WS_VTA); bf16* VT_R = (bf16*)(ws + WS_VTA + 32 * MiB); bf16* KT_A = (bf16*)(ws + WS_SC); bf16* KT_R = (bf16*)(ws + WS_SC + 32 * MiB);
    unsigned char* W_Q8 = ws + WS_WQ; unsigned char* W_KV8 = ws + WS_WKV; unsigned char* W_O8 = ws + WS_WO; unsigned char* MEMN8 = ws + WS_MEMN;
    unsigned char* KVM8 = ws + WS_KVM; unsigned char* WP8 = ws + WS_WP; unsigned char* VPT8 = ws + WS_VPT; unsigned char* PX8 = ws + WS_PX;
    unsigned char* W_IN8 = ws + WS_WIN;
    bf16* W_INB = (bf16*)(ws + WS_WIN + 40 * MiB);
    unsigned char* U8 = ws + WS_U; unsigned char* VT8 = ws + WS_VT; unsigned char* X8 = ws + WS_X8; unsigned char* P8 = ws + WS_P8;
    bf16* PX = (bf16*)(ws + WS_PX); float* SC = (float*)(ws + WS_SC); bf16* QKVN = (bf16*)(ws + WS_QKVN); bf16* VTA = (bf16*)(ws + WS_VTA); unsigned char* MIX8 = ws + WS_MIX; unsigned char* W_OUT8 = ws + WS_WOUT; bf16* GP = (bf16*)(ws + WS_GP); unsigned char* G8 = ws + WS_GP;

    for (int u = tid; u < (LDS_BYTES - LDSCTL_OFF) / 4; u += NWAVES * 64) ((LAS unsigned*)(lds + LDSCTL_OFF))[u] = 0u;
    __syncthreads();
    const int lo = args.ph_lo, hi = args.ph_hi;
    XcdBarrier bar; bar.bar = (unsigned*)(ws + WS_CTL) + CW_BAR; bar.x = 0; bar.st = nullptr;
    if (hi - lo > 1) bar = xcd_barrier_post((unsigned*)(ws + WS_CTL) + CW_BAR, MISC + 8);
#ifndef PHASE_MASK
#define PHASE_MASK 0xffff
#endif
#define IN(k) (((PHASE_MASK >> (k)) & 1) && lo <= (k) && (k) < hi)
#define SEAM(k) do { if (IN(k) && IN((k) + 1)) xcd_barrier(bar); } while (0)
#define SEAM2(k) do { if (IN(k) && IN((k) + 2)) xcd_barrier(bar); } while (0)

    if (IN(0)) {
        { int t_ = tid; asm volatile("" : "+v"(t_)); LAS f32x4* gl4 = (LAS f32x4*)(lds + PQ_OFF); const f32x4* gw4 = (const f32x4*)norm1_w; gl4[t_] = gw4[t_]; gl4[t_ + 512] = gw4[t_ + 512]; }
        __syncthreads();
        LAS float* scr = (LAS float*)(lds + wave * 16896);
        LAS float* scr8 = (LAS float*)(lds + wave * 16896);
        {
            constexpr int J1 = 32 * 192, J1B = 32 * 64, J2 = 32 * 128, J3 = 32 * 256, J4 = 32 * 128, J5 = 128 * 128, NJ = J1 + J1B + J2 + J3 + J4 + J5;
            for (int it = gw; it < NJ; it += NGW) {
                int r = it;
                if (r < J1) { const int n0 = (r % 192) * 32; transpose_item8b(w_in, 4096, 12288, W_IN8, (r / 192) * 128, n0, n0, scr8, lane, 1024.0f); continue; } r -= J1;
                if (r < J1B) { const int n0 = 8192 + (r % 64) * 32; transpose_item8b(w_in, 4096, 12288, W_IN8, (r / 64) * 128, n0, n0 - 2048, scr8, lane, 1024.0f); continue; } r -= J1B;

                if (r < J2) { const int k0 = (r / 128) * 128, n0 = (r % 128) * 32; transpose_item8b(w_out, 4096, 4096, W_OUT8, k0, n0, n0, scr8, lane, k0 < 2048 ? 128.0f : 1024.0f); continue; } r -= J2;
                if (r < J3) { const int n0 = (r % 256) * 32; transpose_item8b(xwkv, 4096, 8192, W_KV8, (r / 256) * 128, n0, n0, scr8, lane, 1024.0f); continue; } r -= J3;
                if (r < J4) { const int n0 = (r % 128) * 32; transpose_item8b(xwo, 4096, 4096, W_O8, (r / 128) * 128, n0, n0, scr8, lane, 1024.0f); continue; } r -= J4;
                { const int n0 = (r % 128) * 32; transpose_item8b(pv, 16384, 4096, VT8, (r / 128) * 128, n0, n0, scr8, lane, 32.0f); }
            }
        }
        {
            for (int it = gw; it < 64 * 64; it += NGW) { const int kb = it / 64, q_ = it % 64; const int n0 = q_ < 32 ? 6144 + q_ * 64 : 10240 + (q_ - 32) * 64;
                int dr = q_ < 32 ? n0 - 6144 : 2048 + n0 - 10240;
                if (q_ < 32) { const int t_old = (dr >> 6) & 3; dr = (dr & ~255) + 64 * (2 * (t_old & 1) + (t_old >> 1)); }
                transpose_item(w_in, 4096, 12288, W_INB, kb * 64, n0, dr, scr, lane); }
        }
        for (int it = gw; it < 8192; it += NGW) convert_item8(xwq, W_Q8, (size_t)it, lane, 1024.0f * norm2_w[it >> 1], nullptr);
        for (int it = gw; it < 32768; it += NGW) convert_item8(pu, U8, (size_t)it, lane, 1024.0f, norm3_w);
        rms_rows_bf16_fp8(x, (const LAS float*)(lds + PQ_OFF), XN, X8, gw, NGW, T, lane);
        for (int m = gw; m < TM; m += NGW) rms_row_fp8(mem + (size_t)m * D, memn_w, MEMN8 + (size_t)m * D, lane);
        for (int it = gw; it < 4096; it += NGW) wpp_item(pwq, psk, norm3_w, W_PP, it, lane);
    }
    SEAM(0);
    if (IN(1)) {
        { pg8::Gemm g{XN, W_INB, 4096, 4096, 4096}; pg8::SchedPlain S; S.init(32, 16, G, bx); pg8::EpiBf16Rot E{QKVN + 4096, 8192, KT_R};
          pg8::gemm_phase<pg8::EpiBf16Rot, pg8::SchedPlain>(lds + RING_OFF, g, S, E); }
        { pg8::Gemm g{(const bf16*)ws, (const bf16*)ws, 2048, 2048, 2048};
          pg8::SchedP1 S{G, bx, WS_X8, WS_WIN, WS_MEMN, WS_WKV};
          pg8::EpiP1 E{pg8::EpiBf16QK{QKVN, 8192, KT_A}, pg8::EpiBf16S{QKVN + 4096 + 2048, 8192, 1.0f}, pg8::EpiBf16VT{VT_A, 7, 16}, pg8::EpiBf16VT{VT_R, 8, 8}, pg8::EpiFp8S{KVM8, 8192, 16.0f}};
          pg8::gemm_phase<pg8::EpiP1, pg8::SchedP1, true, 113>(lds + RING_OFF, g, S, E); }
        if (bx >= 128 || G < 256) {
            const int nz = (G < 256) ? G : G - 128, zi = (G < 256) ? bx : bx - 128;
            u32x4* gz = (u32x4*)P8; const size_t n16 = (size_t)T * NEXP / 16;
            for (size_t i = (size_t)zi * 512 + tid; i < n16; i += (size_t)nz * 512) gz[i] = (u32x4){0u, 0u, 0u, 0u};
        }
    }
    SEAM(1);
    if (IN(2)) {
        if (args.sub & 1) {
        { pg8::Gemm g{(const bf16*)KVM8, (const bf16*)W_Q8, 4096, 2048, 512}; pg8::SchedWp S; S.init(16, 16, G, bx); S.es = 1; pg8::EpiFp8S E{WP8, 4096, 32.0f};
          pg8::gemm_phase<pg8::EpiFp8S, pg8::SchedWp, true, 113>(lds + RING_OFF, g, S, E); }
        { pg8::Gemm g{(const bf16*)W_O8, (const bf16*)KVM8, 2048, 4096, 512}; pg8::SchedVp S; S.init(16, 16, G, bx); S.es = 1; pg8::EpiFp8S E{VPT8, 1024, 32.0f};
          pg8::gemm_phase<pg8::EpiFp8S, pg8::SchedVp, true, 113>(lds + RING_OFF, g, S, E); }
        }
        if (args.sub & 2)
        for (int p = vcu; p < 256; p += G) { const int bh = p >> 2, k = p & 3;
            attn_unit(lds, QKVN, KT_A, VT_A, MIX8, rel_bias, bh >> 4, bh & 15, 7 - k, tid, wave, lane);
            attn_unit(lds, QKVN, KT_A, VT_A, MIX8, rel_bias, bh >> 4, bh & 15, k, tid, wave, lane); }
        if (args.sub & 4)
        for (int p = vcu; p < 256; p += G) { const int bh = p >> 3, j = p & 7;
            ret_unit(lds, QKVN, KT_R, VT_R, MIX8, gn_w, bh >> 3, bh & 7, 15 - j, tid, wave, lane);
            ret_unit(lds, QKVN, KT_R, VT_R, MIX8, gn_w, bh >> 3, bh & 7, j, tid, wave, lane); }
        __syncthreads();
    }
    SEAM(2);
    if (IN(3)) {
        pg8::Gemm g{(const bf16*)MIX8, (const bf16*)W_OUT8, 2048, 2048, 2048}; pg8::SchedPlain S; S.init(32, 16, G, bx); pg8::EpiResNorm<false> E{x, XN, X8, RP1, lds + XCH_OFF};
        pg8::gemm_phase<pg8::EpiResNorm<false>, pg8::SchedPlain, true, 113>(lds + RING_OFF, g, S, E);
    }
    SEAM2(3);
    if (IN(5)) {
        pg8::Gemm g{(const bf16*)X8, (const bf16*)WP8, 2048, 2048, 2048}; pg8::SchedS S; S.init(32, 4, G, bx); S.es = 1; pg8::EpiSoftmax E{PX8, 1024, lds + XCH_OFF, 0.03125f * LOG2E, RP1, lds + RS_OFF};
        pg8::gemm_phase<pg8::EpiSoftmax, pg8::SchedS, true, 118>(lds + RING_OFF, g, S, E);
        if (bx >= 128 || G < 256) {
            const int nz = (G < 256) ? G : G - 128, zi = (G < 256) ? bx : bx - 128;
            u32x4* gz = (u32x4*)G8; const size_t n16 = (size_t)T * NEXP / 16;
            for (size_t i = (size_t)zi * 512 + tid; i < n16; i += (size_t)nz * 512) gz[i] = (u32x4){0u, 0u, 0u, 0u};
        }
    }
    SEAM(5);
    if (IN(6)) {
        pg8::Gemm g{(const bf16*)PX8, (const bf16*)VPT8, 512, 512, 512}; pg8::SchedO S; S.init(32, 16, G, bx); S.es = 1; pg8::EpiResNorm<true> E{XN, XN, X8, RP2, lds + XCH_OFF};
        pg8::gemm_phase<pg8::EpiResNorm<true>, pg8::SchedO, true, 114>(lds + RING_OFF, g, S, E);
    }
    SEAM2(6);
    if (IN(8)) {
        pg8::Gemm g{XN, W_PP, 4096, 4096, 4096}; pg8::SchedPlain S; S.init(32, 8, G, bx); pg8::EpiF32 E{SC, 2048, RP2, lds + RS_OFF};
        pg8::gemm_phase<pg8::EpiF32, pg8::SchedPlain>(lds + RING_OFF, g, S, E);
    }
    SEAM(8);
    if (IN(9)) { topk_phase(lds, SC, G8, gw, NGW, wave, lane); }
    SEAM(9);
    if (IN(10)) {
        pg8::Gemm g{(const bf16*)X8, (const bf16*)U8, 2048, 2048, 2048}; pg8::SchedPlain S; S.init(32, 64, G, bx); pg8::EpiPeer8 E{G8, P8, NEXP, RP2, lds + RS_OFF, lds + PQ_OFF};
        pg8::gemm_phase<pg8::EpiPeer8, pg8::SchedPlain, true, 113>(lds + RING_OFF, g, S, E);
    }
    SEAM(10);
    if (IN(11)) {
        pg8::Gemm g{(const bf16*)P8, (const bf16*)VT8, NEXP / 2, NEXP / 2, NEXP / 2}; pg8::SchedPlain S; S.init(32, 16, G, bx); pg8::EpiResBf16 E{XN};
        pg8::gemm_phase<pg8::EpiResBf16, pg8::SchedPlain, true, 117>(lds + RING_OFF, g, S, E);
    }
    SEAM(11);
#ifdef DBG_CHECK
    if (IN(13)) {
        for (int t = gw; t < T; t += NGW) {
            float sum = 0.f; int bad = 0;
#if DBG_CHECK == 1
            const u32x4* gr = (const u32x4*)(GP + (size_t)t * NEXP);
            for (int i = 0; i < 32; ++i) { const u32x4 w = gr[i * 64 + lane];
                for (int e = 0; e < 4; ++e) { const float a = bf_lo(w[e]), b = bf_hi(w[e]); if (!(fabsf(a) < 1e30f) || !(fabsf(b) < 1e30f)) bad = 1; sum += a + b; } }
            sum = wave_sum(sum); bad = __any(bad) ? 1 : 0;
            if (!(sum > 7.9f && sum < 8.1f)) bad = 1;
#elif DBG_CHECK == 3 || DBG_CHECK == 4
            const u32x4* gr = (DBG_CHECK == 3) ? (const u32x4*)(XN + (size_t)t * D) : (const u32x4*)(W_PP + (size_t)(t & 2047) * D);
            for (int i = 0; i < 8; ++i) { const u32x4 w = gr[i * 64 + lane];
                for (int e = 0; e < 4; ++e) { const float a = bf_lo(w[e]), b = bf_hi(w[e]); if (!(fabsf(a) < 1e30f) || !(fabsf(b) < 1e30f)) bad = 1; sum += a * a + b * b; } }
            sum = wave_sum(sum); bad = __any(bad) ? 1 : 0;
            if (DBG_CHECK == 3) { if (!(sum > 2048.f && sum < 8192.f)) bad = 1; } else { if (!(sum > 0.5f && sum < 2.0f)) bad = 1; }
#else
            const f32x4* sr4 = (const f32x4*)(SC + (size_t)t * 2048);
            for (int i = 0; i < 8; ++i) { const f32x4 w = sr4[i * 64 + lane]; for (int e = 0; e < 4; ++e) { if (!(fabsf(w[e]) < 1e4f)) bad = 1; sum += w[e] * w[e]; } }
            sum = wave_sum(sum); bad = __any(bad) ? 1 : 0;
            if (!(sum > 2048.f * 0.5f && sum < 2048.f * 2.0f)) bad = 1;
#endif
            if (bad) { f32x4* hr = (f32x4*)(hout + (size_t)t * D); for (int j = 0; j < 16; ++j) hr[64 * j + lane] = (f32x4){0.f, 0.f, 0.f, 0.f}; }
        }
    }
#endif
    if (IN(12)) {
        { int t_ = tid; asm volatile("" : "+v"(t_)); LAS f32x4* gl4 = (LAS f32x4*)(lds + PQ_OFF); const f32x4* gw4 = (const f32x4*)fin_w; gl4[t_] = gw4[t_]; gl4[t_ + 512] = gw4[t_ + 512]; }
        __syncthreads();
        int ln_ = (int)__builtin_amdgcn_mbcnt_hi(~0u, __builtin_amdgcn_mbcnt_lo(~0u, 0u)); asm volatile("" : "+v"(ln_));
        rms_rows_bf16_to_f32(XN, (const LAS float*)(lds + PQ_OFF), hout, gw, NGW, T, ln_); }
#undef IN
#undef SEAM
}

extern "C" void kernel_launch(void* const* d_in, const int* in_sizes, int n_in, void* d_out, int out_size, void* d_ws, size_t ws_size, hipStream_t stream) {
    static int grid = 0;
    if (grid == 0) {
        if (n_in != 18 || in_sizes[0] != T * D || out_size != T * D || ws_size < WS_END) { fprintf(stderr, "kernel_launch: unexpected shapes (n_in %d, in0 %d, out %d, ws %zu < %zu); nothing launched\n", n_in, n_in > 0 ? in_sizes[0] : -1, out_size, ws_size, (size_t)WS_END); grid = -1; return; }
        int dev = 0, cus = 0, per_cu = 0;
        if (hipGetDevice(&dev) != hipSuccess || hipDeviceGetAttribute(&cus, hipDeviceAttributeMultiprocessorCount, dev) != hipSuccess) { fprintf(stderr, "kernel_launch: device query failed\n"); grid = -1; return; }
        if (hipFuncSetAttribute((const void*)fwd, hipFuncAttributeMaxDynamicSharedMemorySize, LDS_BYTES) != hipSuccess) { fprintf(stderr, "kernel_launch: hipFuncSetAttribute failed\n"); grid = -1; return; }
        if (hipOccupancyMaxActiveBlocksPerMultiprocessor(&per_cu, (const void*)fwd, NWAVES * 64, LDS_BYTES) != hipSuccess || per_cu < 1) fprintf(stderr, "kernel_launch: note: occupancy query reports %d workgroups per CU\n", per_cu);
        (void)hipGetLastError();
        grid = cus;
    }
    if (grid < 0) return;
    if (hipMemsetAsync((char*)d_ws + WS_CTL, 0, CTL_ZERO_BYTES, stream) != hipSuccess) { fprintf(stderr, "kernel_launch: memset failed\n"); return; }
    Args a{};
    for (int i = 0; i < 18; ++i) a.in[i] = (const float*)d_in[i];
    a.out = (float*)d_out; a.ws = (unsigned char*)d_ws;
#if MK_PER_PHASE
    { const int order[] = { PROBE_ORDER }; const int subs[] = { PROBE_SUBS };
      for (unsigned q = 0; q < sizeof(order) / sizeof(int); ++q) { a.ph_lo = order[q]; a.ph_hi = order[q] + 1; a.sub = subs[q]; hipLaunchKernelGGL(fwd, dim3(grid), dim3(NWAVES * 64), LDS_BYTES, stream, a); } }
#else
    a.ph_lo = 0; a.ph_hi = NPHASE; a.sub = 7; hipLaunchKernelGGL(fwd, dim3(grid), dim3(NWAVES * 64), LDS_BYTES, stream, a);
#endif
    const hipError_t le = hipPeekAtLastError();
    if (le != hipSuccess) fprintf(stderr, "kernel_launch: launch failed: %s\n", hipGetErrorName(le));
}
```

```cpp
#include <hip/hip_runtime.h>
#include <cstdio>
#include <cstdint>

#ifndef MK_PER_PHASE
#define MK_PER_PHASE 0
#endif
#ifndef PROBE_ORDER
#define PROBE_ORDER 0,1,2,3,4,5,6,7,8,9,10,11,12
#define PROBE_SUBS  7,7,7,7,7,7,7,7,7,7,7,7,7
#endif

#define LAS __attribute__((address_space(3)))
#define GAS __attribute__((address_space(1)))
typedef unsigned short bf16;
typedef short bf16x8 __attribute__((ext_vector_type(8)));
typedef float f32x4 __attribute__((ext_vector_type(4)));
typedef float f32x2 __attribute__((ext_vector_type(2)));
typedef unsigned u32x4 __attribute__((ext_vector_type(4)));
typedef unsigned u32x2 __attribute__((ext_vector_type(2)));

constexpr int D = 4096, NB = 4, SEQ = 2048, T = NB * SEQ;
constexpr int MEM = 256, TM = NB * MEM;
constexpr int NEXP = 16384;
constexpr float EPS = 1e-6f;
constexpr float LOG2E = 1.4426950408889634f;

typedef __bf16 bf16x2v __attribute__((ext_vector_type(2)));
__device__ __forceinline__ unsigned cvt_pk_bf16(float lo, float hi) { const f32x2 v = {lo, hi}; return __builtin_bit_cast(unsigned, __builtin_convertvector(v, bf16x2v)); }
typedef int i32x4 __attribute__((ext_vector_type(4)));
typedef int i32x8 __attribute__((ext_vector_type(8)));
__device__ __forceinline__ float f8c(float x) { return fminf(fmaxf(x, -448.0f), 448.0f); }
__device__ __forceinline__ unsigned pk4_fp8(float a, float b, float c, float d) { int r = __builtin_amdgcn_cvt_pk_fp8_f32(f8c(a), f8c(b), 0, false); r = __builtin_amdgcn_cvt_pk_fp8_f32(f8c(c), f8c(d), r, true); return (unsigned)r; }
__device__ __forceinline__ float bf_lo(unsigned w) { return __builtin_bit_cast(float, w << 16); }
__device__ __forceinline__ float bf_hi(unsigned w) { return __builtin_bit_cast(float, w & 0xffff0000u); }

constexpr int PQ_WAVE = 2752, PQ_CAP = PQ_WAVE / 32;
namespace pg8 {
constexpr int BM = 256, BK = 64, HALF = 128, HTB = HALF * BK * 2, STAGE_BYTES = 8 * HTB, NXCD = 8, WGM = 8;
__host__ __device__ __forceinline__ int lds_byte(int r, int c) { const int st = (r >> 4) * 2 + (c >> 5), rr = r & 15, cc = c & 31, ob = rr * 64 + cc * 2; return st * 1024 + (ob ^ (((ob >> 9) & 1) << 5)); }
__host__ __device__ __forceinline__ void stage_rc(int b, int& R, int& C) { const int st = b / 1024, sb = b % 1024, swz = sb ^ (((sb >> 9) & 1) << 5); R = (st >> 1) * 16 + swz / 64; C = (st & 1) * 32 + (swz % 64) / 2; }
__host__ __device__ __forceinline__ int perm32(int rho) { const int n = rho >> 4, i = rho & 15; return 8 * (i >> 2) + 4 * n + (i & 3); }

struct Unit { int pm, pn, orow, ocol, kind; };
struct Gemm { const bf16* A; const bf16* Bt; int lda, ldb, K; };

struct TileOrder {
    int nM, nN, nwg, G, c;
    __device__ __forceinline__ void init(int nM_, int nN_, int G_, int c_) { nM = nM_; nN = nN_; nwg = nM * nN; G = G_; c = c_; }
    __device__ __forceinline__ bool tile(int i, int& pm, int& pn) const {
        const long L = (long)i * G + c; if (L >= nwg) return false;
        int wgid = (int)L; { const int q = nwg / NXCD, r = nwg % NXCD, xcd = wgid % NXCD, off = wgid / NXCD; wgid = (xcd < r ? xcd * (q + 1) : r * (q + 1) + (xcd - r) * q) + off; }
        const int nig = WGM * nN, gid = wgid / nig, fm = gid * WGM, gsz = (nM - fm) < WGM ? (nM - fm) : WGM;
        pm = fm + ((wgid % nig) % gsz); pn = (wgid % nig) / gsz; return true;
    }
};
struct SchedPlain : TileOrder {
    __device__ __forceinline__ bool next(int i, Unit& u) const { if (!tile(i, u.pm, u.pn)) return false; u.orow = u.pm * BM; u.ocol = u.pn * BM; return true; }
    __device__ __forceinline__ size_t offA(const Unit& u, const Gemm& g) const { return (size_t)u.pm * BM * g.lda * 2; }
    __device__ __forceinline__ size_t offB(const Unit& u, const Gemm& g) const { return (size_t)u.pn * BM * g.ldb * 2; }
};
struct SchedWp : TileOrder {
    int es;
    __device__ __forceinline__ bool next(int i, Unit& u) const { if (!tile(i, u.pm, u.pn)) return false; u.orow = u.pm * BM; u.ocol = u.pn * BM; return true; }
    __device__ __forceinline__ size_t offA(const Unit& u, const Gemm&) const { return ((size_t)(u.pm >> 2) * 256 * 8192 + (size_t)(u.pm & 3) * 1024) * es; }
    __device__ __forceinline__ size_t offB(const Unit& u, const Gemm&) const { return ((size_t)u.pn * 256 * 4096 + (size_t)(u.pm & 3) * 1024) * es; }
};
struct SchedVp : TileOrder {
    int es;
    __device__ __forceinline__ bool next(int i, Unit& u) const { if (!tile(i, u.pm, u.pn)) return false; u.orow = (u.pn >> 2) * 4096 + u.pm * BM; u.ocol = (u.pn & 3) * BM; return true; }
    __device__ __forceinline__ size_t offA(const Unit& u, const Gemm&) const { return ((size_t)u.pm * 256 * 4096 + (size_t)(u.pn & 3) * 1024) * es; }
    __device__ __forceinline__ size_t offB(const Unit& u, const Gemm&) const { return ((size_t)(u.pn >> 2) * 256 * 8192 + 4096 + (size_t)(u.pn & 3) * 1024) * es; }
};
struct SchedS : TileOrder {
    int es;
    __device__ __forceinline__ bool next(int i, Unit& u) const { if (!tile(i, u.pm, u.pn)) return false; u.orow = u.pm * BM; u.ocol = u.pn * BM; return true; }
    __device__ __forceinline__ size_t offA(const Unit& u, const Gemm&) const { return (size_t)u.pm * 256 * 4096 * es; }
    __device__ __forceinline__ size_t offB(const Unit& u, const Gemm&) const { return ((size_t)(u.pm >> 3) * 1024 + (size_t)u.pn * 256) * 4096 * es; }
};
struct SchedO : TileOrder {
    int es;
    __device__ __forceinline__ bool next(int i, Unit& u) const { if (!tile(i, u.pm, u.pn)) return false; u.orow = u.pm * BM; u.ocol = u.pn * BM; return true; }
    __device__ __forceinline__ size_t offA(const Unit& u, const Gemm&) const { return (size_t)u.pm * 256 * 1024 * es; }
    __device__ __forceinline__ size_t offB(const Unit& u, const Gemm&) const { return ((size_t)(u.pm >> 3) * 4096 + (size_t)u.pn * 256) * 1024 * es; }
};

struct SchedP1 {
    int G, c; size_t x8, win8, memn8, wkv8;
    __device__ __forceinline__ static void tile_lin(int wgid, int nM, int nN, int& pm, int& pn) {
        const int nwg = nM * nN; { const int q = nwg / NXCD, r = nwg % NXCD, xcd = wgid % NXCD, off = wgid / NXCD; wgid = (xcd < r ? xcd * (q + 1) : r * (q + 1) + (xcd - r) * q) + off; }
        const int nig = WGM * nN, gid = wgid / nig, fm = gid * WGM, gsz = (nM - fm) < WGM ? (nM - fm) : WGM;
        pm = fm + ((wgid % nig) % gsz); pn = (wgid % nig) / gsz;
    }
    __device__ __forceinline__ bool next(int i, Unit& u) const {
        const long L = (long)i * G + c; if (L >= 1408) return false;
        int l = (int)L, k, nM, nN;
        if (l < 512) { k = 0; nM = 32; nN = 16; } else if (l < 768) { k = 1; l -= 512; nM = 32; nN = 8; } else if (l < 1024) { k = 2; l -= 768; nM = 8; nN = 32; }
        else if (l < 1280) { k = 3; l -= 1024; nM = 8; nN = 32; } else { k = 4; l -= 1280; nM = 4; nN = 32; }
        tile_lin(l, nM, nN, u.pm, u.pn); u.orow = u.pm * BM; u.ocol = u.pn * BM; u.kind = k; return true;
    }
    __device__ __forceinline__ size_t offA(const Unit& u, const Gemm&) const { const size_t t = (size_t)u.pm * BM * 4096;
        return u.kind < 2 ? x8 + t : u.kind == 2 ? win8 + (size_t)4096 * 4096 + t : u.kind == 3 ? win8 + (size_t)6144 * 4096 + t : memn8 + t; }
    __device__ __forceinline__ size_t offB(const Unit& u, const Gemm&) const { const size_t t = (size_t)u.pn * BM * 4096;
        return u.kind == 0 ? win8 + t : u.kind == 1 ? win8 + (size_t)8192 * 4096 + t : u.kind < 4 ? x8 + t : wkv8 + t; }
};

__device__ __forceinline__ f32x2 gelu_pk(f32x2 v) {
    const f32x2 av = __builtin_elementwise_abs(v), d = av * 0.2316418882f + 1.0f;
    f32x2 t; t.x = __builtin_amdgcn_rcpf(d.x); t.y = __builtin_amdgcn_rcpf(d.y);
    f32x2 q = t * 0.5307027145f + (-0.7265760135f); q = q * t + 0.7107068705f; q = q * t + (-0.142248368f); q = q * t + 0.127414796f; q = q * t;
    const f32x2 s = (v * v) * (-0.72134752044f);
    f32x2 e; e.x = __builtin_amdgcn_exp2f(s.x); e.y = __builtin_amdgcn_exp2f(s.y);
    const f32x2 pos = {fmaxf(v.x, 0.f), fmaxf(v.y, 0.f)};
    return pos - av * (q * e);
}

struct EpiBf16S {
    static constexpr bool PERM = true, HAS_BEGIN = false;
    bf16* O; int ldc; float scale;
    __device__ __forceinline__ void operator()(f32x4 (&acc)[2][2][4][2], const Unit& u, int wr, int wc, int fr, int fq, int par) const {
        const int row0 = u.orow + wr * 64 + fr, col0 = u.ocol + wc * 32 + 8 * fq;
#pragma unroll
        for (int ai = 0; ai < 2; ++ai)
#pragma unroll
            for (int m = 0; m < 4; ++m) { bf16* rowp = O + (size_t)(row0 + ai * HALF + m * 16) * ldc + col0;
#pragma unroll
                for (int bj = 0; bj < 2; ++bj) { const f32x4 v0 = acc[ai][bj][m][0] * scale, v1 = acc[ai][bj][m][1] * scale;
                    u32x4 w; w.x = cvt_pk_bf16(v0[0], v0[1]); w.y = cvt_pk_bf16(v0[2], v0[3]); w.z = cvt_pk_bf16(v1[0], v1[1]); w.w = cvt_pk_bf16(v1[2], v1[3]);
                    *(u32x4*)(rowp + bj * HALF) = w; } }
    }
};
__device__ __forceinline__ float row_rs(const float* rowpart, int row) {
    const f32x4* p = (const f32x4*)(rowpart + (size_t)row * 16); const f32x4 a = p[0], b = p[1], c = p[2], d = p[3];
    const float s = (((a[0] + a[1]) + (a[2] + a[3])) + ((b[0] + b[1]) + (b[2] + b[3]))) + (((c[0] + c[1]) + (c[2] + c[3])) + ((d[0] + d[1]) + (d[2] + d[3])));
    return 1.0f / sqrtf(s * (1.0f / 4096.0f) + 1e-6f);
}
__device__ __forceinline__ void rs_begin(const float* rowpart, LAS unsigned char* rs_tab, int orow, int par) { const int t = threadIdx.x; if (t < 256) ((LAS float*)rs_tab)[par * 256 + t] = row_rs(rowpart, orow + t); }
template <bool BASE_BF16> struct EpiResNorm {
    static constexpr bool PERM = true, HAS_BEGIN = false;
    const void* base; bf16* hb; unsigned char* x8; float* rowpart; LAS unsigned char* xch;
    __device__ __forceinline__ void operator()(f32x4 (&acc)[2][2][4][2], const Unit& u, int wr, int wc, int fr, int fq, int par) const {
        const int row0 = u.orow + wr * 64 + fr, col0 = u.ocol + wc * 32 + 8 * fq;
        LAS float* X = (LAS float*)xch;
#pragma unroll
        for (int ai = 0; ai < 2; ++ai)
#pragma unroll
            for (int m = 0; m < 4; ++m) { const size_t off = (size_t)(row0 + ai * HALF + m * 16) * 4096 + col0;
                f32x4 bs[2][2];
#pragma unroll
                for (int bj = 0; bj < 2; ++bj) {
                    if constexpr (BASE_BF16) { const u32x4 w = *(const u32x4*)((const bf16*)base + off + bj * HALF);
                        bs[bj][0] = (f32x4){bf_lo(w.x), bf_hi(w.x), bf_lo(w.y), bf_hi(w.y)}; bs[bj][1] = (f32x4){bf_lo(w.z), bf_hi(w.z), bf_lo(w.w), bf_hi(w.w)}; }
                    else { bs[bj][0] = *(const f32x4*)((const float*)base + off + bj * HALF); bs[bj][1] = *(const f32x4*)((const float*)base + off + bj * HALF + 4); } }
                float ss = 0.f;
#pragma unroll
                for (int bj = 0; bj < 2; ++bj) { const f32x4 o0 = bs[bj][0] + acc[ai][bj][m][0], o1 = bs[bj][1] + acc[ai][bj][m][1];
                    ss += ((o0[0] * o0[0] + o0[1] * o0[1]) + (o0[2] * o0[2] + o0[3] * o0[3])) + ((o1[0] * o1[0] + o1[1] * o1[1]) + (o1[2] * o1[2] + o1[3] * o1[3]));
                    u32x2 q; q.x = pk4_fp8(16.f * o0[0], 16.f * o0[1], 16.f * o0[2], 16.f * o0[3]); q.y = pk4_fp8(16.f * o1[0], 16.f * o1[1], 16.f * o1[2], 16.f * o1[3]);
                    *(u32x2*)(x8 + off + bj * HALF) = q;
                    u32x4 w; w.x = cvt_pk_bf16(o0[0], o0[1]); w.y = cvt_pk_bf16(o0[2], o0[3]); w.z = cvt_pk_bf16(o1[0], o1[1]); w.w = cvt_pk_bf16(o1[2], o1[3]); *(u32x4*)(hb + off + bj * HALF) = w; }
                ss += __shfl_xor(ss, 16); ss += __shfl_xor(ss, 32);
                if (fq == 0) X[(ai * HALF + wr * 64 + m * 16 + fr) * 4 + wc] = ss;
                asm volatile("" ::: "memory"); }
        asm volatile("s_waitcnt lgkmcnt(0)" ::: "memory"); __builtin_amdgcn_s_barrier(); asm volatile("" ::: "memory");
        if (wc == 0 && fq == 0) {
#pragma unroll
            for (int ai = 0; ai < 2; ++ai)
#pragma unroll
                for (int m = 0; m < 4; ++m) { const int rl = ai * HALF + wr * 64 + m * 16 + fr; const f32x4 p = *(const LAS f32x4*)(X + rl * 4);
                    rowpart[(size_t)(u.orow + rl) * 16 + u.pn] = (p[0] + p[1]) + (p[2] + p[3]); }
        }
    }
};
struct EpiResBf16 {
    static constexpr bool PERM = true, HAS_BEGIN = false;
    bf16* hb;
    __device__ __forceinline__ void operator()(f32x4 (&acc)[2][2][4][2], const Unit& u, int wr, int wc, int fr, int fq, int par) const {
        const int row0 = u.orow + wr * 64 + fr, col0 = u.ocol + wc * 32 + 8 * fq;
#pragma unroll
        for (int ai = 0; ai < 2; ++ai)
#pragma unroll
            for (int m = 0; m < 4; ++m) { bf16* rowp = hb + (size_t)(row0 + ai * HALF + m * 16) * 4096 + col0;
                u32x4 bw[2];
#pragma unroll
                for (int bj = 0; bj < 2; ++bj) bw[bj] = *(const u32x4*)(rowp + bj * HALF);
#pragma unroll
                for (int bj = 0; bj < 2; ++bj) { const u32x4 b = bw[bj]; const f32x4 v0 = acc[ai][bj][m][0], v1 = acc[ai][bj][m][1];
                    u32x4 w; w.x = cvt_pk_bf16(bf_lo(b.x) + v0[0], bf_hi(b.x) + v0[1]); w.y = cvt_pk_bf16(bf_lo(b.y) + v0[2], bf_hi(b.y) + v0[3]);
                    w.z = cvt_pk_bf16(bf_lo(b.z) + v1[0], bf_hi(b.z) + v1[1]); w.w = cvt_pk_bf16(bf_lo(b.w) + v1[2], bf_hi(b.w) + v1[3]); *(u32x4*)(rowp + bj * HALF) = w; }
                asm volatile("" ::: "memory"); }
    }
};
struct EpiBf16VT {
    static constexpr bool PERM = true, HAS_BEGIN = false;
    bf16* O; int dvlog2, H;
    __device__ __forceinline__ void operator()(f32x4 (&acc)[2][2][4][2], const Unit& u, int wr, int wc, int fr, int fq, int par) const {
        const int row0 = u.orow + wr * 64 + fr, col0 = u.ocol + wc * 32 + 8 * fq;
#pragma unroll
        for (int ai = 0; ai < 2; ++ai)
#pragma unroll
            for (int m = 0; m < 4; ++m) { const int n = row0 + ai * HALF + m * 16; const int h = n >> dvlog2, d = n & ((1 << dvlog2) - 1);
#pragma unroll
                for (int bj = 0; bj < 2; ++bj) { const int t = col0 + bj * HALF; const int b = t >> 11, mc = (t >> 6) & 31, i = t & 63;
                    const f32x4 v0 = acc[ai][bj][m][0], v1 = acc[ai][bj][m][1];
                    const int p0 = (i & 32) + 16 * ((i >> 3) & 1) + 4 * ((i >> 4) & 1);
                    u32x2 w0, w1; w0.x = cvt_pk_bf16(v0[0], v0[1]); w0.y = cvt_pk_bf16(v0[2], v0[3]); w1.x = cvt_pk_bf16(v1[0], v1[1]); w1.y = cvt_pk_bf16(v1[2], v1[3]);
                    bf16* rp = O + ((((size_t)(b * H + h) * 32 + mc) << dvlog2) + d) * 64 + p0; *(u32x2*)rp = w0; *(u32x2*)(rp + 8) = w1; } }
    }
};
struct EpiBf16QK {
    static constexpr bool PERM = true, HAS_BEGIN = false;
    bf16* O; int ldc; bf16* KT;
    __device__ __forceinline__ void operator()(f32x4 (&acc)[2][2][4][2], const Unit& u, int wr, int wc, int fr, int fq, int par) const {
        const int row0 = u.orow + wr * 64 + fr, col0 = u.ocol + wc * 32 + 8 * fq;
#pragma unroll
        for (int ai = 0; ai < 2; ++ai)
#pragma unroll
            for (int m = 0; m < 4; ++m) { const int row = row0 + ai * HALF + m * 16; const int b = row >> 11, mc = (row >> 6) & 31, i = row & 63;
#pragma unroll
                for (int bj = 0; bj < 2; ++bj) { const f32x4 v0 = acc[ai][bj][m][0], v1 = acc[ai][bj][m][1];
                    u32x4 w; w.x = cvt_pk_bf16(v0[0], v0[1]); w.y = cvt_pk_bf16(v0[2], v0[3]); w.z = cvt_pk_bf16(v1[0], v1[1]); w.w = cvt_pk_bf16(v1[2], v1[3]);
                    if (u.ocol < 2048) *(u32x4*)(O + (size_t)row * ldc + col0 + bj * HALF) = w;
                    else { const int h = ((u.ocol - 2048) >> 7) + bj, d = wc * 32 + 8 * fq; *(u32x4*)(KT + ((((size_t)(b * 16 + h) * 32 + mc) * 64 + i) << 7) + d) = w; } } }
    }
};
struct EpiBf16Rot {
    static constexpr bool PERM = true, HAS_BEGIN = false;
    bf16* O; int ldc; bf16* KT;
    __device__ __forceinline__ void operator()(f32x4 (&acc)[2][2][4][2], const Unit& u, int wr, int wc, int fr, int fq, int par) const {
        const int row0 = u.orow + wr * 64 + fr;
        if (u.ocol < 2048) {
            const int d0 = 32 * (wc & 1) + 8 * fq; float invf[8];
#pragma unroll
            for (int e = 0; e < 8; ++e) invf[e] = __builtin_amdgcn_exp2f((float)(d0 + e) * (-13.287712379549449f / 64.0f)) * 0.15915494309189535f;
            bf16* obase = O + u.ocol + (wc >> 1) * 128 + d0;
#pragma unroll
            for (int ai = 0; ai < 2; ++ai)
#pragma unroll
                for (int m = 0; m < 4; ++m) { const int row = row0 + ai * HALF + m * 16; const float pos = (float)(row & (SEQ - 1));
                    float lo[8], hi[8];
#pragma unroll
                    for (int e = 0; e < 8; ++e) { const float rev = pos * invf[e], frc = rev - floorf(rev); const float sn = __builtin_amdgcn_sinf(frc), cs = __builtin_amdgcn_cosf(frc);
                        const float x1 = acc[ai][0][m][e >> 2][e & 3], x2 = acc[ai][1][m][e >> 2][e & 3]; lo[e] = x1 * cs - x2 * sn; hi[e] = x1 * sn + x2 * cs; }
                    u32x4 wl, wh; wl.x = cvt_pk_bf16(lo[0], lo[1]); wl.y = cvt_pk_bf16(lo[2], lo[3]); wl.z = cvt_pk_bf16(lo[4], lo[5]); wl.w = cvt_pk_bf16(lo[6], lo[7]);
                    wh.x = cvt_pk_bf16(hi[0], hi[1]); wh.y = cvt_pk_bf16(hi[2], hi[3]); wh.z = cvt_pk_bf16(hi[4], hi[5]); wh.w = cvt_pk_bf16(hi[6], hi[7]);
                    if (u.ocol < 1024) { bf16* rowp = obase + (size_t)row * ldc; *(u32x4*)rowp = wl; *(u32x4*)(rowp + 64) = wh; }
                    else { const int b = row >> 11, mc = (row >> 6) & 31, i = row & 63, h = ((u.ocol - 1024) >> 7) + (wc >> 1);
                        bf16* kp = KT + ((((size_t)(b * 8 + h) * 32 + mc) * 64 + i) << 7) + d0; *(u32x4*)kp = wl; *(u32x4*)(kp + 64) = wh; } }
        } else {
            const int col0 = u.ocol + wc * 32 + 8 * fq;
#pragma unroll
            for (int ai = 0; ai < 2; ++ai)
#pragma unroll
                for (int m = 0; m < 4; ++m) { bf16* rowp = O + (size_t)(row0 + ai * HALF + m * 16) * ldc + col0;
#pragma unroll
                    for (int bj = 0; bj < 2; ++bj) { const f32x4 v0 = acc[ai][bj][m][0], v1 = acc[ai][bj][m][1];
                        u32x4 w; w.x = cvt_pk_bf16(v0[0], v0[1]); w.y = cvt_pk_bf16(v0[2], v0[3]); w.z = cvt_pk_bf16(v1[0], v1[1]); w.w = cvt_pk_bf16(v1[2], v1[3]);
                        *(u32x4*)(rowp + bj * HALF) = w; } }
        }
    }
};
struct EpiFp8S {
    static constexpr bool PERM = true, HAS_BEGIN = false;
    unsigned char* O; int ldc; float scale;
    __device__ __forceinline__ void operator()(f32x4 (&acc)[2][2][4][2], const Unit& u, int wr, int wc, int fr, int fq, int par) const {
        const int row0 = u.orow + wr * 64 + fr, col0 = u.ocol + wc * 32 + 8 * fq;
#pragma unroll
        for (int ai = 0; ai < 2; ++ai)
#pragma unroll
            for (int m = 0; m < 4; ++m) { unsigned char* rowp = O + (size_t)(row0 + ai * HALF + m * 16) * ldc + col0;
#pragma unroll
                for (int bj = 0; bj < 2; ++bj) { const f32x4 v0 = acc[ai][bj][m][0] * scale, v1 = acc[ai][bj][m][1] * scale;
                    u32x2 w; w.x = pk4_fp8(v0[0], v0[1], v0[2], v0[3]); w.y = pk4_fp8(v1[0], v1[1], v1[2], v1[3]);
                    *(u32x2*)(rowp + bj * HALF) = w; } }
    }
};
struct EpiP1 {
    static constexpr bool PERM = true, HAS_BEGIN = false;
    EpiBf16QK e0; EpiBf16S e1; EpiBf16VT e2, e3; EpiFp8S e4;
    __device__ __forceinline__ void operator()(f32x4 (&acc)[2][2][4][2], const Unit& u, int wr, int wc, int fr, int fq, int par) const {
        if (u.kind == 0) e0(acc, u, wr, wc, fr, fq, par); else if (u.kind == 1) e1(acc, u, wr, wc, fr, fq, par); else if (u.kind == 2) e2(acc, u, wr, wc, fr, fq, par);
        else if (u.kind == 3) e3(acc, u, wr, wc, fr, fq, par); else e4(acc, u, wr, wc, fr, fq, par);
    }
};
struct EpiF32 {
    static constexpr bool PERM = false, HAS_BEGIN = true;
    float* C; int ldc; const float* rowpart; LAS unsigned char* rs_tab;
    __device__ __forceinline__ void begin(const Unit& u, int par) const { rs_begin(rowpart, rs_tab, u.orow, par); }
    __device__ __forceinline__ void operator()(f32x4 (&acc)[2][2][4][2], const Unit& u, int wr, int wc, int fr, int fq, int par) const {
        const int row0 = u.orow + wr * 64 + fr, col0 = u.ocol + wc * 32 + 4 * fq;
#pragma unroll
        for (int ai = 0; ai < 2; ++ai)
#pragma unroll
            for (int m = 0; m < 4; ++m) { const float rs = ((const LAS float*)rs_tab)[par * 256 + ai * HALF + wr * 64 + m * 16 + fr]; float* rowp = C + (size_t)(row0 + ai * HALF + m * 16) * ldc + col0;
#pragma unroll
                for (int bj = 0; bj < 2; ++bj)
#pragma unroll
                    for (int n = 0; n < 2; ++n) *(f32x4*)(rowp + bj * HALF + n * 16) = acc[ai][bj][m][n] * rs; }
    }
};
struct EpiResF32 {
    static constexpr bool PERM = false, HAS_BEGIN = false;
    const float* base; float* out; int ldc;
    __device__ __forceinline__ void operator()(f32x4 (&acc)[2][2][4][2], const Unit& u, int wr, int wc, int fr, int fq, int par) const {
        const int row0 = u.orow + wr * 64 + fr, col0 = u.ocol + wc * 32 + 4 * fq;
#pragma unroll
        for (int ai = 0; ai < 2; ++ai)
#pragma unroll
            for (int m = 0; m < 4; ++m) { const size_t off = (size_t)(row0 + ai * HALF + m * 16) * ldc + col0;
                f32x4 bs[2][2];
#pragma unroll
                for (int bj = 0; bj < 2; ++bj)
#pragma unroll
                    for (int n = 0; n < 2; ++n) bs[bj][n] = *(const f32x4*)(base + off + bj * HALF + n * 16);
#pragma unroll
                for (int bj = 0; bj < 2; ++bj)
#pragma unroll
                    for (int n = 0; n < 2; ++n) *(f32x4*)(out + off + bj * HALF + n * 16) = bs[bj][n] + acc[ai][bj][m][n];
                asm volatile("" ::: "memory"); }
    }
};
struct EpiSoftmax {
    static constexpr bool PERM = true, HAS_BEGIN = true;
    unsigned char* O; int ldc; LAS unsigned char* xch; float pre; const float* rowpart; LAS unsigned char* rs_tab;
    __device__ __forceinline__ void begin(const Unit& u, int par) const { rs_begin(rowpart, rs_tab, u.orow, par); }
    __device__ __forceinline__ void operator()(f32x4 (&acc)[2][2][4][2], const Unit& u, int wr, int wc, int fr, int fq, int par) const {
        LAS f32x2* X = (LAS f32x2*)xch;
        float mloc[2][4];
#pragma unroll
        for (int ai = 0; ai < 2; ++ai)
#pragma unroll
            for (int m = 0; m < 4; ++m) {
                float mx = -3.0e38f; const float prs = pre * ((const LAS float*)rs_tab)[par * 256 + ai * HALF + wr * 64 + m * 16 + fr];
#pragma unroll
                for (int bj = 0; bj < 2; ++bj)
#pragma unroll
                    for (int n = 0; n < 2; ++n) { const f32x4 x = acc[ai][bj][m][n] * prs; acc[ai][bj][m][n] = x; mx = fmaxf(mx, fmaxf(fmaxf(x[0], x[1]), fmaxf(x[2], x[3]))); }
                mx = fmaxf(mx, __shfl_xor(mx, 16)); mx = fmaxf(mx, __shfl_xor(mx, 32));
                float s = 0.f;
#pragma unroll
                for (int bj = 0; bj < 2; ++bj)
#pragma unroll
                    for (int n = 0; n < 2; ++n) { f32x4 x = acc[ai][bj][m][n];
#pragma unroll
                        for (int j = 0; j < 4; ++j) { x[j] = __builtin_amdgcn_exp2f(x[j] - mx); s += x[j]; }
                        acc[ai][bj][m][n] = x; }
                s += __shfl_xor(s, 16); s += __shfl_xor(s, 32);
                mloc[ai][m] = mx;
                if (fq == 0) X[(ai * HALF + wr * 64 + m * 16 + fr) * 4 + wc] = (f32x2){mx, s};
            }
        asm volatile("s_waitcnt lgkmcnt(0)" ::: "memory"); __builtin_amdgcn_s_barrier(); asm volatile("" ::: "memory");
        const int row0 = u.orow + wr * 64 + fr, col0 = u.ocol + wc * 32 + 8 * fq;
#pragma unroll
        for (int ai = 0; ai < 2; ++ai)
#pragma unroll
            for (int m = 0; m < 4; ++m) {
                const int rl = ai * HALF + wr * 64 + m * 16 + fr;
                const f32x2 p0 = X[rl * 4 + 0], p1 = X[rl * 4 + 1], p2 = X[rl * 4 + 2], p3 = X[rl * 4 + 3];
                const float gm = fmaxf(fmaxf(p0.x, p1.x), fmaxf(p2.x, p3.x));
                const float gl = p0.y * __builtin_amdgcn_exp2f(p0.x - gm) + p1.y * __builtin_amdgcn_exp2f(p1.x - gm) + p2.y * __builtin_amdgcn_exp2f(p2.x - gm) + p3.y * __builtin_amdgcn_exp2f(p3.x - gm);
                const float f = 256.0f * __builtin_amdgcn_exp2f(mloc[ai][m] - gm) / gl;
                unsigned char* rowp = O + (size_t)(row0 + ai * HALF + m * 16) * ldc + col0;
#pragma unroll
                for (int bj = 0; bj < 2; ++bj) { const f32x4 v0 = acc[ai][bj][m][0] * f, v1 = acc[ai][bj][m][1] * f;
                    u32x2 w; w.x = pk4_fp8(v0[0], v0[1], v0[2], v0[3]); w.y = pk4_fp8(v1[0], v1[1], v1[2], v1[3]);
                    *(u32x2*)(rowp + bj * HALF) = w; }
            }
    }
};
struct EpiPeer {
    static constexpr bool PERM = true, HAS_BEGIN = false;
    bf16* GP; int ldc;
    __device__ __forceinline__ void operator()(f32x4 (&acc)[2][2][4][2], const Unit& u, int wr, int wc, int fr, int fq, int par) const {
        const int row0 = u.orow + wr * 64 + fr, col0 = u.ocol + wc * 32 + 8 * fq;
#pragma unroll
        for (int ai = 0; ai < 2; ++ai) {
            u32x4 g[4][2];
#pragma unroll
            for (int m = 0; m < 4; ++m)
#pragma unroll
                for (int bj = 0; bj < 2; ++bj) g[m][bj] = *(const u32x4*)(GP + (size_t)(row0 + ai * HALF + m * 16) * ldc + col0 + bj * HALF);
#pragma unroll
            for (int m = 0; m < 4; ++m) { bf16* rowp = GP + (size_t)(row0 + ai * HALF + m * 16) * ldc + col0;
#pragma unroll
                for (int bj = 0; bj < 2; ++bj) { const f32x4 v0 = acc[ai][bj][m][0], v1 = acc[ai][bj][m][1]; const u32x4 gg = g[m][bj];
                    const f32x2 a = gelu_pk((f32x2){v0[0], v0[1]}), b = gelu_pk((f32x2){v0[2], v0[3]}), c = gelu_pk((f32x2){v1[0], v1[1]}), d = gelu_pk((f32x2){v1[2], v1[3]});
                    u32x4 w; w.x = cvt_pk_bf16(a.x * bf_lo(gg.x), a.y * bf_hi(gg.x)); w.y = cvt_pk_bf16(b.x * bf_lo(gg.y), b.y * bf_hi(gg.y));
                    w.z = cvt_pk_bf16(c.x * bf_lo(gg.z), c.y * bf_hi(gg.z)); w.w = cvt_pk_bf16(d.x * bf_lo(gg.w), d.y * bf_hi(gg.w));
                    *(u32x4*)(rowp + bj * HALF) = w; } }
        }
    }
};

struct EpiPeer8 {
    static constexpr bool PERM = true, HAS_BEGIN = true;
    const unsigned char* G; unsigned char* P8; int ldc; const float* rowpart; LAS unsigned char* rs_tab; LAS unsigned char* pq;
    __device__ __forceinline__ void begin(const Unit& u, int par) const { rs_begin(rowpart, rs_tab, u.orow, par); }
    __device__ __forceinline__ void drain(LAS u32x4* Q, int n, int lane) const {
        for (int r = lane; r < n; r += 64) {
            const u32x4 e0 = Q[2 * r], e1 = Q[2 * r + 1];
            const f32x2 a = gelu_pk((f32x2){bf_lo(e0.x), bf_hi(e0.x)}), b = gelu_pk((f32x2){bf_lo(e0.y), bf_hi(e0.y)}), c = gelu_pk((f32x2){bf_lo(e0.z), bf_hi(e0.z)}), d = gelu_pk((f32x2){bf_lo(e0.w), bf_hi(e0.w)});
            u32x2 w; w.x = pk4_fp8(0.25f * a.x * (float)(e1.x & 255u), 0.25f * a.y * (float)((e1.x >> 8) & 255u), 0.25f * b.x * (float)((e1.x >> 16) & 255u), 0.25f * b.y * (float)(e1.x >> 24));
            w.y = pk4_fp8(0.25f * c.x * (float)(e1.y & 255u), 0.25f * c.y * (float)((e1.y >> 8) & 255u), 0.25f * d.x * (float)((e1.y >> 16) & 255u), 0.25f * d.y * (float)(e1.y >> 24));
            *(u32x2*)(P8 + e1.z) = w;
        }
    }
    __device__ __forceinline__ void operator()(f32x4 (&acc)[2][2][4][2], const Unit& u, int wr, int wc, int fr, int fq, int par) const {
        const int row0 = u.orow + wr * 64 + fr, col0 = u.ocol + wc * 32 + 8 * fq, lane = 16 * fq + fr;
        LAS u32x4* Q = (LAS u32x4*)(pq + (wr * 4 + wc) * PQ_WAVE);
        u32x2 g2[2][4][2];
#pragma unroll
        for (int ai = 0; ai < 2; ++ai)
#pragma unroll
            for (int m = 0; m < 4; ++m)
#pragma unroll
                for (int bj = 0; bj < 2; ++bj) g2[ai][m][bj] = *(const u32x2*)(G + ((((size_t)(u.pm * 64 + u.pn) * 8 + (size_t)(wr * 4 + wc)) * 16 + (size_t)((ai * 4 + m) * 2 + bj)) * 64 + (size_t)lane) * 8);
        int n = 0;
#pragma unroll
        for (int ai = 0; ai < 2; ++ai)
#pragma unroll
            for (int m = 0; m < 4; ++m) { const float rs = ((const LAS float*)rs_tab)[par * 256 + ai * HALF + wr * 64 + m * 16 + fr]; const unsigned roff = (unsigned)(row0 + ai * HALF + m * 16) * (unsigned)ldc + (unsigned)col0;
#pragma unroll
                for (int bj = 0; bj < 2; ++bj) { const u32x2 gg = g2[ai][m][bj]; const bool nz = (gg.x | gg.y) != 0u;
                    const unsigned long long mask = __ballot(nz);
                    if (mask != 0ull) {
                        const int cnt = __builtin_popcountll(mask);
                        if (n + cnt > PQ_CAP) { drain(Q, n, lane); n = 0; }
                        if (nz) { const int pos = n + (int)__builtin_amdgcn_mbcnt_hi((unsigned)(mask >> 32), __builtin_amdgcn_mbcnt_lo((unsigned)mask, 0u));
                            const f32x4 v0 = acc[ai][bj][m][0] * rs, v1 = acc[ai][bj][m][1] * rs;
                            u32x4 e0; e0.x = cvt_pk_bf16(v0[0], v0[1]); e0.y = cvt_pk_bf16(v0[2], v0[3]); e0.z = cvt_pk_bf16(v1[0], v1[1]); e0.w = cvt_pk_bf16(v1[2], v1[3]);
                            Q[2 * pos] = e0; Q[2 * pos + 1] = (u32x4){gg.x, gg.y, roff + (unsigned)(bj * HALF), 0u}; }
                        n += cnt;
                    } } }
        drain(Q, n, lane);
    }
};

template <class Epi, class Sched, bool FP8 = false, int SC8 = 127, bool ALIGN_EPI = true, bool SP2 = true>
__device__ __forceinline__ void gemm_phase(LAS unsigned char* lds, const Gemm g, const Sched& S, const Epi& E) {
    const int tid = threadIdx.x, wid = __builtin_amdgcn_readfirstlane(tid >> 6), lane = tid & 63, wr = wid >> 2, wc = wid & 3, fr = lane & 15, fq = lane >> 4;
    const int K = g.K, nt = K / BK;
    unsigned voffA[2], voffB[2];
#pragma unroll
    for (int i = 0; i < 2; ++i) { int R, C; stage_rc(tid * 16 + i * 8192, R, C); const int Rb = Epi::PERM ? ((R & ~31) + perm32(R & 31)) : R;
        voffA[i] = (unsigned)(R * g.lda + C) * 2u; voffB[i] = (unsigned)(Rb * g.ldb + C) * 2u; }
    const size_t kstep = (size_t)(BK * 2);
    const size_t hstepA = (size_t)HALF * g.lda * 2, hstepB = (size_t)HALF * g.ldb * 2;
    const unsigned ldsw = (unsigned)wid * 1024u;
    const int aoff = lds_byte(wr * 64 + fr, fq * 8), boff = lds_byte(wc * 32 + fr, fq * 8);
#define PG8_SA(b, h) (((b) * 2 + (h)) * HTB)
#define PG8_SB(b, h) ((4 + (b) * 2 + (h)) * HTB)
#define PG8_STAGE(bufoff, gbase, voff) do { _Pragma("unroll") for (int _i = 0; _i < 2; ++_i) \
        __builtin_amdgcn_global_load_lds((const unsigned*)((const char*)(gbase) + (voff)[_i]), (LAS unsigned*)(lds + (bufoff) + ldsw + _i * 8192), 16, 0, 0); } while (0)
#define PG8_LDA(dst, b, h) do { _Pragma("unroll") for (int m = 0; m < 4; ++m) dst[m] = __builtin_shufflevector(*(const LAS i32x4*)(lds + PG8_SA(b, h) + aoff + m * 2048), *(const LAS i32x4*)(lds + PG8_SA(b, h) + aoff + m * 2048 + 1024), 0, 1, 2, 3, 4, 5, 6, 7); } while (0)
#define PG8_LDB(dst, b, h) do { _Pragma("unroll") for (int n = 0; n < 2; ++n) dst[n] = __builtin_shufflevector(*(const LAS i32x4*)(lds + PG8_SB(b, h) + boff + n * 2048), *(const LAS i32x4*)(lds + PG8_SB(b, h) + boff + n * 2048 + 1024), 0, 1, 2, 3, 4, 5, 6, 7); } while (0)
#define PG8_H0(v) __builtin_bit_cast(bf16x8, __builtin_shufflevector(v, v, 0, 1, 2, 3))
#define PG8_H1(v) __builtin_bit_cast(bf16x8, __builtin_shufflevector(v, v, 4, 5, 6, 7))
#define PG8_MMA(ai, bj, At, Bt) do { __builtin_amdgcn_s_setprio(1); \
        if constexpr (FP8) { _Pragma("unroll") for (int m = 0; m < 4; ++m) _Pragma("unroll") for (int n = 0; n < 2; ++n) \
            asm volatile("v_mfma_scale_f32_16x16x128_f8f6f4 %0, %1, %2, %0, %3, %4 op_sel_hi:[0,0,0]" : "+v"(acc[ai][bj][m][n]) : "v"(Bt[n]), "v"(At[m]), "v"(sc8a), "v"(sc8b)); } \
        else { _Pragma("unroll") for (int m = 0; m < 4; ++m) _Pragma("unroll") for (int n = 0; n < 2; ++n) { \
            acc[ai][bj][m][n] = __builtin_amdgcn_mfma_f32_16x16x32_bf16(PG8_H0(Bt[n]), PG8_H0(At[m]), acc[ai][bj][m][n], 0, 0, 0); \
            acc[ai][bj][m][n] = __builtin_amdgcn_mfma_f32_16x16x32_bf16(PG8_H1(Bt[n]), PG8_H1(At[m]), acc[ai][bj][m][n], 0, 0, 0); } } __builtin_amdgcn_s_setprio(0); } while (0)
#define PG8_WAIT_V(n) asm volatile("s_waitcnt vmcnt(" #n ")" ::: "memory")
#define PG8_WAIT_L(n) asm volatile("s_waitcnt lgkmcnt(" #n ")" ::: "memory")
#define PG8_BAR __builtin_amdgcn_s_barrier()
#define PG8_SCHED __builtin_amdgcn_sched_barrier(0)
    Unit cur, nxt; int ui = 0;
    if (!S.next(0, cur)) return;
    f32x4 acc[2][2][4][2];
#pragma unroll
    for (int a = 0; a < 2; ++a)
#pragma unroll
        for (int b = 0; b < 2; ++b)
#pragma unroll
            for (int m = 0; m < 4; ++m)
#pragma unroll
                for (int n = 0; n < 2; ++n) acc[a][b][m][n] = (f32x4){0.f, 0.f, 0.f, 0.f};
    i32x8 At[4], B0[2], B1[2];
    const int sc8a = SC8, sc8b = 127;
    const char* cA = (const char*)g.A + S.offA(cur, g); const char* cB = (const char*)g.Bt + S.offB(cur, g);
    if constexpr (Epi::HAS_BEGIN) E.begin(cur, 0);
    if constexpr (SP2) {
        PG8_STAGE(PG8_SB(0, 0), cB, voffB); PG8_STAGE(PG8_SB(0, 1), cB + hstepB, voffB); PG8_STAGE(PG8_SA(0, 0), cA, voffA); PG8_STAGE(PG8_SA(0, 1), cA + hstepA, voffA);
        if (wr == 1) PG8_BAR;
        PG8_WAIT_V(2); PG8_BAR;
        PG8_STAGE(PG8_SB(1, 0), cB + kstep, voffB); PG8_STAGE(PG8_SA(1, 0), cA + kstep, voffA); PG8_STAGE(PG8_SB(1, 1), cB + hstepB + kstep, voffB);
        PG8_WAIT_V(6); PG8_BAR;
    } else {
        PG8_STAGE(PG8_SB(0, 0), cB, voffB); PG8_STAGE(PG8_SA(0, 0), cA, voffA); PG8_STAGE(PG8_SB(0, 1), cB + hstepB, voffB); PG8_STAGE(PG8_SA(0, 1), cA + hstepA, voffA);
        if (wr == 1) PG8_BAR;
        PG8_WAIT_V(4); PG8_BAR;
        PG8_STAGE(PG8_SB(1, 0), cB + kstep, voffB); PG8_STAGE(PG8_SA(1, 0), cA + kstep, voffA); PG8_STAGE(PG8_SB(1, 1), cB + hstepB + kstep, voffB);
        PG8_WAIT_V(6); PG8_BAR;
    }
    for (;;) {
        const bool has_next = S.next(ui + 1, nxt);
        const char* nA = has_next ? (const char*)g.A + S.offA(nxt, g) : cA; const char* nB = has_next ? (const char*)g.Bt + S.offB(nxt, g) : cB;
        for (int t = 0; t < nt; t += 2) {
            const bool last = (t == nt - 2);
            const char* a1 = cA + (size_t)(t + 1) * kstep;
            const char* a2 = last ? nA : cA + (size_t)(t + 2) * kstep; const char* b2 = last ? nB : cB + (size_t)(t + 2) * kstep;
            const char* a3 = a2 + kstep; const char* b3 = b2 + kstep;
            if constexpr (SP2) {
            PG8_LDB(B0, 0, 0); PG8_LDB(B1, 0, 1); PG8_SCHED; PG8_LDA(At, 0, 0); PG8_STAGE(PG8_SA(1, 1), a1 + hstepA, voffA);
            PG8_WAIT_V(8); PG8_WAIT_L(0); PG8_BAR; PG8_MMA(0, 0, At, B0); PG8_MMA(0, 1, At, B1); PG8_BAR; PG8_SCHED;
            PG8_LDA(At, 0, 1); PG8_STAGE(PG8_SB(0, 0), b2, voffB); PG8_STAGE(PG8_SB(0, 1), b2 + hstepB, voffB); PG8_STAGE(PG8_SA(0, 0), a2, voffA);
            PG8_WAIT_V(8); PG8_WAIT_L(0); PG8_BAR; PG8_MMA(1, 0, At, B0); PG8_MMA(1, 1, At, B1); PG8_BAR; PG8_SCHED;
            PG8_LDB(B0, 1, 0); PG8_LDB(B1, 1, 1); PG8_SCHED; PG8_LDA(At, 1, 0); PG8_STAGE(PG8_SA(0, 1), a2 + hstepA, voffA);
            PG8_WAIT_V(8); PG8_WAIT_L(0); PG8_BAR; PG8_MMA(0, 0, At, B0); PG8_MMA(0, 1, At, B1); PG8_BAR; PG8_SCHED;
            PG8_LDA(At, 1, 1); PG8_STAGE(PG8_SB(1, 0), b3, voffB); PG8_STAGE(PG8_SB(1, 1), b3 + hstepB, voffB); PG8_STAGE(PG8_SA(1, 0), a3, voffA);
            PG8_WAIT_V(8); PG8_WAIT_L(0); PG8_BAR; PG8_MMA(1, 0, At, B0); PG8_MMA(1, 1, At, B1); PG8_BAR; PG8_SCHED;
            } else {
            PG8_LDB(B0, 0, 0); PG8_SCHED; PG8_LDA(At, 0, 0); PG8_STAGE(PG8_SA(1, 1), a1 + hstepA, voffA);
            PG8_WAIT_L(8); PG8_BAR; PG8_WAIT_L(0); PG8_MMA(0, 0, At, B0); PG8_BAR; PG8_SCHED;
            PG8_LDB(B1, 0, 1); PG8_STAGE(PG8_SB(0, 0), b2, voffB);
            PG8_BAR; PG8_WAIT_L(0); PG8_MMA(0, 1, At, B1); PG8_BAR;
            PG8_LDA(At, 0, 1); PG8_STAGE(PG8_SA(0, 0), a2, voffA);
            PG8_BAR; PG8_WAIT_L(0); PG8_MMA(1, 0, At, B0); PG8_BAR; PG8_SCHED;
            PG8_STAGE(PG8_SB(0, 1), b2 + hstepB, voffB);
            PG8_WAIT_V(6); PG8_BAR; PG8_MMA(1, 1, At, B1); PG8_BAR;
            PG8_LDB(B0, 1, 0); PG8_SCHED; PG8_LDA(At, 1, 0); PG8_STAGE(PG8_SA(0, 1), a2 + hstepA, voffA);
            PG8_WAIT_L(8); PG8_BAR; PG8_WAIT_L(0); PG8_MMA(0, 0, At, B0); PG8_BAR; PG8_SCHED;
            PG8_LDB(B1, 1, 1); PG8_STAGE(PG8_SB(1, 0), b3, voffB);
            PG8_BAR; PG8_WAIT_L(0); PG8_MMA(0, 1, At, B1); PG8_BAR;
            PG8_LDA(At, 1, 1); PG8_STAGE(PG8_SA(1, 0), a3, voffA);
            PG8_BAR; PG8_WAIT_L(0); PG8_MMA(1, 0, At, B0); PG8_BAR; PG8_SCHED;
            PG8_STAGE(PG8_SB(1, 1), b3 + hstepB, voffB);
            PG8_WAIT_V(6); PG8_BAR; PG8_MMA(1, 1, At, B1); PG8_BAR;
            }
        }
        if constexpr (ALIGN_EPI) { if (wr == 0) PG8_BAR; }
        if constexpr (FP8) asm volatile("s_nop 15\n\ts_nop 15" ::: "memory");
        { int ln_ = (int)__builtin_amdgcn_mbcnt_hi(~0u, __builtin_amdgcn_mbcnt_lo(~0u, 0u)); asm volatile("" : "+v"(ln_));
          E(acc, cur, wr, wc, ln_ & 15, ln_ >> 4, ui & 1); }
        if (!has_next) break;
#pragma unroll
        for (int a = 0; a < 2; ++a)
#pragma unroll
            for (int b = 0; b < 2; ++b)
#pragma unroll
                for (int m = 0; m < 4; ++m)
#pragma unroll
                    for (int n = 0; n < 2; ++n) acc[a][b][m][n] = (f32x4){0.f, 0.f, 0.f, 0.f};
        cur = nxt; cA = nA; cB = nB; ++ui;
        if constexpr (Epi::HAS_BEGIN) E.begin(cur, ui & 1);
        if constexpr (ALIGN_EPI) { if (wr == 1) PG8_BAR; }
    }
    PG8_WAIT_V(0);
    if constexpr (!ALIGN_EPI) { if (wr == 0) PG8_BAR; }
    PG8_BAR;
#undef PG8_SA
#undef PG8_SB
#undef PG8_STAGE
#undef PG8_LDA
#undef PG8_LDB
#undef PG8_MMA
#undef PG8_H0
#undef PG8_H1
#undef PG8_WAIT_V
#undef PG8_WAIT_L
#undef PG8_BAR
#undef PG8_SCHED
}
}

constexpr size_t MiB = 1u << 20;
constexpr size_t WS_CTL = 0, CTL_ZERO_BYTES = 1 * MiB;
constexpr size_t WS_WIN = 2 * MiB;
constexpr size_t WS_WOUT = 98 * MiB;
constexpr size_t WS_WQ = 130 * MiB;
constexpr size_t WS_WKV = 162 * MiB;
constexpr size_t WS_WO = 226 * MiB;
constexpr size_t WS_WPP = 258 * MiB;
constexpr size_t WS_U = 274 * MiB;
constexpr size_t WS_VT = 402 * MiB;
constexpr size_t WS_XN = 530 * MiB;
constexpr size_t WS_MEMN = 594 * MiB;
constexpr size_t WS_KVM = 602 * MiB;
constexpr size_t WS_WP = 618 * MiB;
constexpr size_t WS_VPT = 650 * MiB;
constexpr size_t WS_PX = 682 * MiB;
constexpr size_t WS_SC = 698 * MiB;
constexpr size_t WS_R1 = 762 * MiB;
constexpr size_t WS_QKVN = WS_R1;
constexpr size_t WS_VTA = WS_R1 + 128 * MiB;
constexpr size_t WS_MIX = WS_R1 + 192 * MiB;
constexpr size_t WS_GP = WS_R1;
constexpr size_t WS_X8 = WS_U + 64 * MiB;
constexpr size_t WS_P8 = 1018 * MiB;
constexpr size_t WS_END = 1146 * MiB;
constexpr int CW_BAR = 4096;

constexpr int RING_OFF = 0, RING_BYTES = 131072;
constexpr int XCH_OFF = RING_BYTES, XCH_BYTES = 8192 + 2048;
constexpr int RS_OFF = XCH_OFF + 8192;
constexpr int LDSCTL_OFF = XCH_OFF + XCH_BYTES, MISC_OFF = LDSCTL_OFF + 320;
constexpr int PQ_OFF = MISC_OFF + 128;
constexpr int LDS_BYTES = 163840;
static_assert(PQ_OFF + 8 * PQ_WAVE <= LDS_BYTES && PQ_OFF % 16 == 0, "LDS map");
constexpr int NWAVES = 8;

#define RLX_AGENT __ATOMIC_RELAXED, __HIP_MEMORY_SCOPE_AGENT
#define LDS_WAIT() asm volatile("s_waitcnt lgkmcnt(0)" ::: "memory")
#define VM_WAIT() asm volatile("s_waitcnt vmcnt(0)" ::: "memory")

#define XB_TMO      128
#define XB_XCNT(j)  (256  + 64 * (j))
#define XB_XSUB(j)  (1280 + 64 * (j))
#define XB_XGEN(j)  (2304 + 64 * (j))
#define XB_TOP      3328
#define XB_TOPGEN   3392
#define XCD_BAR_WORDS 3456
#define XB_SPIN_CAP (1u << 18)
__device__ __forceinline__ unsigned xb_ld(unsigned* p)              { return __hip_atomic_load(p, __ATOMIC_RELAXED, __HIP_MEMORY_SCOPE_AGENT); }
__device__ __forceinline__ unsigned xb_add(unsigned* p, unsigned v) { return __hip_atomic_fetch_add(p, v, __ATOMIC_RELAXED, __HIP_MEMORY_SCOPE_AGENT); }
__device__ __forceinline__ unsigned xb_xcc_id() { return (unsigned)__builtin_amdgcn_s_getreg((3 << 11) | 20) & 0xFu; }
#define XB_SPIN(cond, bar) do { unsigned _sp = 0; while (cond) { __builtin_amdgcn_s_sleep(1); \
    if ((++_sp & 255u) == 0u) { if (xb_ld(&(bar)[XB_TMO])) break; if (_sp > XB_SPIN_CAP) { atomicAdd(&(bar)[XB_TMO], 1u); break; } } } } while (0)
struct XcdBarrier { unsigned* bar; unsigned x; volatile LAS unsigned* st; };
__device__ __forceinline__ XcdBarrier xcd_barrier_post(unsigned* bar, volatile LAS unsigned* st) {
    XcdBarrier b; b.bar = bar; b.x = xb_xcc_id(); b.st = st;
    if (threadIdx.x == 0) (void)xb_add(&bar[XB_XCNT(b.x)], 1u);
    return b;
}
__device__ __forceinline__ void xcd_barrier_complete(unsigned* bar, unsigned x, unsigned& nloc, unsigned& nx) {
    const unsigned G = gridDim.x * gridDim.y * gridDim.z;
    unsigned sum, cnt, mine, sp = 0u;
    for (;;) {
        sum = 0u; cnt = 0u; mine = 0u;
#pragma unroll
        for (unsigned j = 0; j < 16; ++j) { const unsigned c = xb_ld(&bar[XB_XCNT(j)]); sum += c; cnt += (c > 0u) ? 1u : 0u; mine = (j == x) ? c : mine; }
        if (sum == G) break;
        __builtin_amdgcn_s_sleep(1);
        if ((++sp & 255u) == 0u) { if (xb_ld(&bar[XB_TMO])) break; if (sp > XB_SPIN_CAP) { atomicAdd(&bar[XB_TMO], 1u); break; } }
    }
    nloc = mine > 0u ? mine : 1u; nx = cnt > 0u ? cnt : 1u;
}
__device__ __forceinline__ void xcd_barrier(const XcdBarrier& b) {
    asm volatile("s_waitcnt vmcnt(0)" ::: "memory");
    __syncthreads();
    if (threadIdx.x == 0) {
        unsigned* bar = b.bar;
        __builtin_amdgcn_s_waitcnt(0);
        unsigned nloc = b.st[0], nx = b.st[1];
        if (nloc == 0u) { xcd_barrier_complete(bar, b.x, nloc, nx); b.st[0] = nloc; b.st[1] = nx; }
        const unsigned old = xb_add(&bar[XB_XSUB(b.x)], 1u);
        const unsigned gen = old / nloc;
        if (old + 1u == (gen + 1u) * nloc) {
            __builtin_amdgcn_fence(__ATOMIC_RELEASE, "agent");
            asm volatile("s_waitcnt vmcnt(0)" ::: "memory");
            const unsigned og = xb_add(&bar[XB_TOP], 1u);
            const unsigned tg = og / nx;
            if (og + 1u == (tg + 1u) * nx) xb_add(&bar[XB_TOPGEN], 1u);
            else XB_SPIN(xb_ld(&bar[XB_TOPGEN]) == tg, bar);
            __builtin_amdgcn_fence(__ATOMIC_ACQUIRE, "agent");
            xb_add(&bar[XB_XGEN(b.x)], 1u);
            asm volatile("s_waitcnt vmcnt(0)" ::: "memory");
        } else {
            XB_SPIN(xb_ld(&bar[XB_XGEN(b.x)]) == gen, bar);
            __builtin_amdgcn_fence(__ATOMIC_ACQUIRE, "agent");
            asm volatile("s_waitcnt vmcnt(0)" ::: "memory");
        }
    }
    __syncthreads();
}

__device__ __forceinline__ float wave_sum(float v) {
#pragma unroll
    for (int o = 1; o < 64; o <<= 1) v += __shfl_xor(v, o);
    return v;
}
__device__ __forceinline__ unsigned wave_max_u32(unsigned v) {
#pragma unroll
    for (int o = 1; o < 64; o <<= 1) { const unsigned t = (unsigned)__shfl_xor((int)v, o); v = t > v ? t : v; }
    return v;
}
__device__ __forceinline__ void rot_cs(int pos, int i, float& c, float& s) {
    const float inv_freq = __builtin_amdgcn_exp2f((float)i * (-13.287712379549449f / 64.0f));
    const float ang = (float)pos * inv_freq;
    const float rev = ang * 0.15915494309189535f;
    const float fr = rev - floorf(rev);
    s = __builtin_amdgcn_sinf(fr); c = __builtin_amdgcn_cosf(fr);
}

__device__ __forceinline__ void rms_row_bf16(const float* xrow, const float* w, bf16* orow, int lane) {
    const f32x4* xr = (const f32x4*)xrow + lane; const f32x4* wr = (const f32x4*)w + lane;
    f32x4 v[16]; float ss = 0.f;
#pragma unroll
    for (int j = 0; j < 16; ++j) { v[j] = xr[64 * j]; ss += (v[j].x * v[j].x + v[j].y * v[j].y) + (v[j].z * v[j].z + v[j].w * v[j].w); }
    const float rs = 1.0f / sqrtf(wave_sum(ss) * (1.0f / D) + EPS);
    u32x2* o8 = (u32x2*)orow + lane;
#pragma unroll
    for (int j = 0; j < 16; ++j) { const f32x4 g = wr[64 * j]; u32x2 o; o.x = cvt_pk_bf16(v[j].x * rs * g.x, v[j].y * rs * g.y); o.y = cvt_pk_bf16(v[j].z * rs * g.z, v[j].w * rs * g.w); o8[64 * j] = o; }
}
__device__ __forceinline__ void rms_row_bf16_to_f32(const bf16* hrow, const float* w, float* orow, int lane) {
    const u32x4* hr = (const u32x4*)hrow + lane; const f32x4* wr = (const f32x4*)w + lane * 2;
    u32x4 v[8]; float ss = 0.f;
#pragma unroll
    for (int j = 0; j < 8; ++j) { v[j] = hr[64 * j];
#pragma unroll
        for (int e = 0; e < 4; ++e) { const float a = bf_lo(v[j][e]), b = bf_hi(v[j][e]); ss += a * a + b * b; } }
    const float rs = 1.0f / sqrtf(wave_sum(ss) * (1.0f / D) + EPS);
    f32x4* o4 = (f32x4*)orow + lane * 2;
#pragma unroll
    for (int j = 0; j < 8; ++j) { const f32x4 g0 = wr[128 * j], g1 = wr[128 * j + 1];
        o4[128 * j] = (f32x4){bf_lo(v[j].x), bf_hi(v[j].x), bf_lo(v[j].y), bf_hi(v[j].y)} * rs * g0;
        o4[128 * j + 1] = (f32x4){bf_lo(v[j].z), bf_hi(v[j].z), bf_lo(v[j].w), bf_hi(v[j].w)} * rs * g1; }
}
__device__ __forceinline__ void rms_row_f32_inplace(float* xrow, const float* w, int lane) {
    f32x4* xr = (f32x4*)xrow + lane; const f32x4* wr = (const f32x4*)w + lane;
    f32x4 v[16]; float ss = 0.f;
#pragma unroll
    for (int j = 0; j < 16; ++j) { v[j] = xr[64 * j];
#ifdef DBG_SCRUB
        for (int e = 0; e < 4; ++e) if (!(fabsf(v[j][e]) < 1.0e30f)) v[j][e] = 0.f;
#endif
        ss += (v[j].x * v[j].x + v[j].y * v[j].y) + (v[j].z * v[j].z + v[j].w * v[j].w); }
    const float rs = 1.0f / sqrtf(wave_sum(ss) * (1.0f / D) + EPS);
#pragma unroll
    for (int j = 0; j < 16; ++j) { const f32x4 g = wr[64 * j]; xr[64 * j] = v[j] * rs * g; }
}
__device__ __forceinline__ void transpose_item(const float* W, int K, int N, bf16* WT, int k0, int n0, int dst_row0, LAS float* scr, int lane) {
    const int rsub = lane >> 4, c4 = (lane & 15) * 4;
    f32x4 tv[16];
#pragma unroll
    for (int i = 0; i < 16; ++i) tv[i] = *(const f32x4*)(W + (size_t)(k0 + 4 * i + rsub) * N + n0 + c4);
#pragma unroll
    for (int i = 0; i < 16; ++i) { LAS float* d = scr + (4 * i + rsub) * 65 + c4; d[0] = tv[i].x; d[1] = tv[i].y; d[2] = tv[i].z; d[3] = tv[i].w; }
    LDS_WAIT(); asm volatile("" ::: "memory");
    const int c = lane & 7;
#pragma unroll
    for (int j = 0; j < 8; ++j) { const int n = (lane >> 3) + 8 * j; const LAS float* s = scr + (8 * c) * 65 + n;
        u32x4 o; o.x = cvt_pk_bf16(s[0 * 65], s[1 * 65]); o.y = cvt_pk_bf16(s[2 * 65], s[3 * 65]); o.z = cvt_pk_bf16(s[4 * 65], s[5 * 65]); o.w = cvt_pk_bf16(s[6 * 65], s[7 * 65]);
        *(u32x4*)(WT + (size_t)(dst_row0 + n) * K + k0 + 8 * c) = o; }
    LDS_WAIT(); asm volatile("" ::: "memory");
}
__device__ __forceinline__ void convert_item(const float* src, bf16* dst, size_t item, int lane) {
    const f32x4* s = (const f32x4*)(src + item * 2048) + lane * 2; u32x4* d = (u32x4*)(dst + item * 2048) + lane;
#pragma unroll
    for (int j = 0; j < 4; ++j) { const f32x4 a = s[128 * j], b = s[128 * j + 1]; u32x4 o; o.x = cvt_pk_bf16(a.x, a.y); o.y = cvt_pk_bf16(a.z, a.w); o.z = cvt_pk_bf16(b.x, b.y); o.w = cvt_pk_bf16(b.z, b.w); d[64 * j] = o; }
}
__device__ __forceinline__ void convert_item8(const float* src, unsigned char* dst, size_t item, int lane, float scale, const float* colgain) {
    const f32x4* s = (const f32x4*)(src + item * 2048) + lane * 4; u32x4* d = (u32x4*)(dst + item * 2048) + lane;
    const f32x4* cg = colgain ? (const f32x4*)(colgain + (item & 1) * 2048) + lane * 4 : nullptr;
#pragma unroll
    for (int j = 0; j < 2; ++j) { f32x4 a = s[256 * j] * scale, b = s[256 * j + 1] * scale, c = s[256 * j + 2] * scale, e = s[256 * j + 3] * scale;
        if (cg) { a = a * cg[256 * j]; b = b * cg[256 * j + 1]; c = c * cg[256 * j + 2]; e = e * cg[256 * j + 3]; }
        u32x4 o; o.x = pk4_fp8(a.x, a.y, a.z, a.w); o.y = pk4_fp8(b.x, b.y, b.z, b.w); o.z = pk4_fp8(c.x, c.y, c.z, c.w); o.w = pk4_fp8(e.x, e.y, e.z, e.w); d[64 * j] = o; }
}
__device__ __forceinline__ void transpose_item8(const float* W, int K, int N, unsigned char* WT, int k0, int n0, int dst_row0, LAS float* scr, int lane, float scale) {
    const int rsub = lane >> 4, c4 = (lane & 15) * 4;
    f32x4 tv[16];
#pragma unroll
    for (int i = 0; i < 16; ++i) tv[i] = *(const f32x4*)(W + (size_t)(k0 + 4 * i + rsub) * N + n0 + c4);
#pragma unroll
    for (int i = 0; i < 16; ++i) { const f32x4 v = tv[i] * scale; LAS float* d = scr + (4 * i + rsub) * 65 + c4; d[0] = v.x; d[1] = v.y; d[2] = v.z; d[3] = v.w; }
    LDS_WAIT(); asm volatile("" ::: "memory");
    const int c = lane & 3;
#pragma unroll
    for (int j = 0; j < 4; ++j) { const int n = (lane >> 2) + 16 * j; const LAS float* s = scr + (16 * c) * 65 + n;
        u32x4 o; o.x = pk4_fp8(s[0 * 65], s[1 * 65], s[2 * 65], s[3 * 65]); o.y = pk4_fp8(s[4 * 65], s[5 * 65], s[6 * 65], s[7 * 65]);
        o.z = pk4_fp8(s[8 * 65], s[9 * 65], s[10 * 65], s[11 * 65]); o.w = pk4_fp8(s[12 * 65], s[13 * 65], s[14 * 65], s[15 * 65]);
        *(u32x4*)(WT + (size_t)(dst_row0 + n) * K + k0 + 16 * c) = o; }
    LDS_WAIT(); asm volatile("" ::: "memory");
}
__device__ __forceinline__ void transpose_item8b(const float* W, int K, int N, unsigned char* WT, int k0, int n0, int dst_row0, LAS float* scr, int lane, float scale) {
    const int rsub = lane >> 3, c4 = (lane & 7) * 4;
    f32x4 tv[16];
#pragma unroll
    for (int i = 0; i < 16; ++i) tv[i] = *(const f32x4*)(W + (size_t)(k0 + 8 * i + rsub) * N + n0 + c4);
#pragma unroll
    for (int i = 0; i < 16; ++i) { const f32x4 v = tv[i] * scale; LAS float* d = scr + (8 * i + rsub) * 33 + c4; d[0] = v.x; d[1] = v.y; d[2] = v.z; d[3] = v.w; }
    LDS_WAIT(); asm volatile("" ::: "memory");
#pragma unroll
    for (int jn = 0; jn < 2; ++jn)
#pragma unroll
        for (int jc = 0; jc < 2; ++jc) { const int n = (lane & 15) + 16 * jn, c = (lane >> 4) + 4 * jc; const LAS float* sp = scr + (16 * c) * 33 + n;
            u32x4 o; o.x = pk4_fp8(sp[0 * 33], sp[1 * 33], sp[2 * 33], sp[3 * 33]); o.y = pk4_fp8(sp[4 * 33], sp[5 * 33], sp[6 * 33], sp[7 * 33]);
            o.z = pk4_fp8(sp[8 * 33], sp[9 * 33], sp[10 * 33], sp[11 * 33]); o.w = pk4_fp8(sp[12 * 33], sp[13 * 33], sp[14 * 33], sp[15 * 33]);
            *(u32x4*)(WT + (size_t)(dst_row0 + n) * K + k0 + 16 * c) = o; }
    LDS_WAIT(); asm volatile("" ::: "memory");
}
__device__ __forceinline__ void rms_row_fp8(const float* xrow, const float* w, unsigned char* o8row, int lane) {
    const f32x4* xr = (const f32x4*)xrow + lane; const f32x4* wr = (const f32x4*)w + lane;
    f32x4 v[16]; float ss = 0.f;
#pragma unroll
    for (int j = 0; j < 16; ++j) { v[j] = xr[64 * j]; ss += (v[j].x * v[j].x + v[j].y * v[j].y) + (v[j].z * v[j].z + v[j].w * v[j].w); }
    const float rs = 16.0f / sqrtf(wave_sum(ss) * (1.0f / D) + EPS);
    unsigned* q8 = (unsigned*)o8row + lane;
#pragma unroll
    for (int j = 0; j < 16; ++j) { const f32x4 g = wr[64 * j]; const f32x4 y = v[j] * rs * g; q8[64 * j] = pk4_fp8(y.x, y.y, y.z, y.w); }
}
__device__ __forceinline__ void rms_row_bf16_fp8(const float* xrow, const float* w, bf16* orow, unsigned char* o8row, int lane) {
    const f32x4* xr = (const f32x4*)xrow + lane; const f32x4* wr = (const f32x4*)w + lane;
    f32x4 v[16]; float ss = 0.f;
#pragma unroll
    for (int j = 0; j < 16; ++j) { v[j] = xr[64 * j]; ss += (v[j].x * v[j].x + v[j].y * v[j].y) + (v[j].z * v[j].z + v[j].w * v[j].w); }
    const float rs = 1.0f / sqrtf(wave_sum(ss) * (1.0f / D) + EPS);
    u32x2* o8 = (u32x2*)orow + lane; unsigned* q8 = (unsigned*)o8row + lane;
#pragma unroll
    for (int j = 0; j < 16; ++j) { const f32x4 g = wr[64 * j]; const f32x4 y = v[j] * rs * g; u32x2 o; o.x = cvt_pk_bf16(y.x, y.y); o.y = cvt_pk_bf16(y.z, y.w); o8[64 * j] = o;
        q8[64 * j] = pk4_fp8(16.f * y.x, 16.f * y.y, 16.f * y.z, 16.f * y.w); }
}
__device__ __forceinline__ void rms_rows_bf16_fp8(const float* x, const LAS float* gl, bf16* xn, unsigned char* x8, int gw, int ngw, int nrows, int lane) {
    if (gw >= nrows) return;
    f32x4 cur[16], nxt[16];
    { const f32x4* xr = (const f32x4*)(x + (size_t)gw * D) + lane;
#pragma unroll
      for (int j = 0; j < 16; ++j) cur[j] = xr[64 * j]; }
    const LAS f32x4* g4 = (const LAS f32x4*)gl + lane;
    for (int m = gw; m < nrows; m += ngw) {
        const bool more = m + ngw < nrows;
        if (more) { const f32x4* xr = (const f32x4*)(x + (size_t)(m + ngw) * D) + lane;
#pragma unroll
            for (int j = 0; j < 16; ++j) nxt[j] = xr[64 * j]; }
        __builtin_amdgcn_sched_barrier(0);
        float ss = 0.f;
#pragma unroll
        for (int j = 0; j < 16; ++j) ss += (cur[j].x * cur[j].x + cur[j].y * cur[j].y) + (cur[j].z * cur[j].z + cur[j].w * cur[j].w);
        const float rs = 1.0f / sqrtf(wave_sum(ss) * (1.0f / D) + EPS);
        u32x2* o8 = (u32x2*)(xn + (size_t)m * D) + lane; unsigned* q8 = (unsigned*)(x8 + (size_t)m * D) + lane;
#pragma unroll
        for (int j = 0; j < 16; ++j) { const f32x4 y = cur[j] * rs * g4[64 * j]; u32x2 o; o.x = cvt_pk_bf16(y.x, y.y); o.y = cvt_pk_bf16(y.z, y.w); o8[64 * j] = o;
            q8[64 * j] = pk4_fp8(16.f * y.x, 16.f * y.y, 16.f * y.z, 16.f * y.w); }
        __builtin_amdgcn_sched_barrier(0);
        if (more) {
#pragma unroll
            for (int j = 0; j < 16; ++j) cur[j] = nxt[j]; }
    }
}
__device__ __forceinline__ void rms_rows_bf16_to_f32(const bf16* h, const LAS float* gl, float* out, int gw, int ngw, int nrows, int lane) {
    if (gw >= nrows) return;
    u32x4 cur[8], nxt[8];
    { const u32x4* hr = (const u32x4*)(h + (size_t)gw * D) + lane;
#pragma unroll
      for (int j = 0; j < 8; ++j) cur[j] = hr[64 * j]; }
    const LAS f32x4* g4 = (const LAS f32x4*)gl + lane * 2;
    for (int m = gw; m < nrows; m += ngw) {
        const bool more = m + ngw < nrows;
        if (more) { const u32x4* hr = (const u32x4*)(h + (size_t)(m + ngw) * D) + lane;
#pragma unroll
            for (int j = 0; j < 8; ++j) nxt[j] = hr[64 * j]; }
        __builtin_amdgcn_sched_barrier(0);
        float ss = 0.f;
#pragma unroll
        for (int j = 0; j < 8; ++j)
#pragma unroll
            for (int e = 0; e < 4; ++e) { const float a = bf_lo(cur[j][e]), b = bf_hi(cur[j][e]); ss += a * a + b * b; }
        const float rs = 1.0f / sqrtf(wave_sum(ss) * (1.0f / D) + EPS);
        f32x4* o4 = (f32x4*)(out + (size_t)m * D) + lane * 2;
#pragma unroll
        for (int j = 0; j < 8; ++j) { const f32x4 g0 = g4[128 * j], g1 = g4[128 * j + 1];
            o4[128 * j] = (f32x4){bf_lo(cur[j].x), bf_hi(cur[j].x), bf_lo(cur[j].y), bf_hi(cur[j].y)} * rs * g0;
            o4[128 * j + 1] = (f32x4){bf_lo(cur[j].z), bf_hi(cur[j].z), bf_lo(cur[j].w), bf_hi(cur[j].w)} * rs * g1; }
        __builtin_amdgcn_sched_barrier(0);
        if (more) {
#pragma unroll
            for (int j = 0; j < 8; ++j) cur[j] = nxt[j]; }
    }
}
__device__ __forceinline__ bf16x8 ld8_f32_bf16(const float* p) { const f32x4 a = *(const f32x4*)p, b = *(const f32x4*)(p + 4); u32x4 o; o.x = cvt_pk_bf16(a.x, a.y); o.y = cvt_pk_bf16(a.z, a.w); o.z = cvt_pk_bf16(b.x, b.y); o.w = cvt_pk_bf16(b.z, b.w); return __builtin_bit_cast(bf16x8, o); }
__device__ __forceinline__ bf16x8 cvt8_bf16(const f32x4 a, const f32x4 b) { u32x4 o; o.x = cvt_pk_bf16(a.x, a.y); o.y = cvt_pk_bf16(a.z, a.w); o.z = cvt_pk_bf16(b.x, b.y); o.w = cvt_pk_bf16(b.z, b.w); return __builtin_bit_cast(bf16x8, o); }
__device__ __forceinline__ void wpp_item(const float* wq, const float* sk, const float* cgain, bf16* WppT, int item, int lane) {
    const int hp = item >> 8, c0 = (item & 255) * 16, fr = lane & 15, fq = lane >> 4;
    f32x4 araw[4][2];
#pragma unroll
    for (int ds = 0; ds < 4; ++ds) { const float* pa = wq + (size_t)(c0 + fr) * 2048 + hp * 128 + 32 * ds + 8 * fq; araw[ds][0] = *(const f32x4*)pa; araw[ds][1] = *(const f32x4*)(pa + 4); }
    const f32x4 cg = *(const f32x4*)(cgain + c0 + 4 * fq);
    bf16x8 af[4];
#pragma unroll
    for (int h2 = 0; h2 < 2; ++h2) {
        f32x4 braw[4][4][2];
#pragma unroll
        for (int k4 = 0; k4 < 4; ++k4)
#pragma unroll
            for (int ds = 0; ds < 4; ++ds) { const float* pb = sk + ((size_t)hp * 128 + 16 * (4 * h2 + k4) + fr) * 128 + 32 * ds + 8 * fq; braw[k4][ds][0] = *(const f32x4*)pb; braw[k4][ds][1] = *(const f32x4*)(pb + 4); }
        __builtin_amdgcn_sched_barrier(0);
        if (h2 == 0) {
#pragma unroll
            for (int ds = 0; ds < 4; ++ds) af[ds] = cvt8_bf16(araw[ds][0], araw[ds][1]); }
#pragma unroll
        for (int k4 = 0; k4 < 4; ++k4) { const int kt = 4 * h2 + k4;
            f32x4 acc = (f32x4){0.f, 0.f, 0.f, 0.f};
#pragma unroll
            for (int ds = 0; ds < 4; ++ds) acc = __builtin_amdgcn_mfma_f32_16x16x32_bf16(af[ds], cvt8_bf16(braw[k4][ds][0], braw[k4][ds][1]), acc, 0, 0, 0);
            acc = acc * cg;
            u32x2 o; o.x = cvt_pk_bf16(acc[0], acc[1]); o.y = cvt_pk_bf16(acc[2], acc[3]);
            *(u32x2*)(WppT + (size_t)(hp * 128 + 16 * kt + fr) * 4096 + c0 + 4 * fq) = o; }
        __builtin_amdgcn_sched_barrier(0);
    }
}

constexpr int ATT_K0 = 0, ATT_KB = 16384, ATT_V0 = 32768, ATT_VB = 40960, ATT_VROW = 160;
static_assert(ATT_V0 + 2 * ATT_VB <= RING_BYTES, "attention LDS");

__device__ __forceinline__ void attn_unit(LAS unsigned char* lds, const bf16* __restrict__ qkvn, const bf16* __restrict__ kT, const bf16* __restrict__ vT, unsigned char* __restrict__ mix, const float* __restrict__ rel_bias,
                                          int b, int h, int qb, int tid, int wid, int lane) {
    asm volatile("" : "+v"(tid), "+v"(lane), "+s"(wid));
    const int fr = lane & 15, fq = lane >> 4;
    LAS float* biasl = (LAS float*)(lds + XCH_OFF);
    __syncthreads();
    for (int i = tid; i < 832; i += 512) biasl[i] = rel_bias[h * 513 + (i < 512 ? i : 512)] * LOG2E;
    const int t0 = b * SEQ + qb * 256;
    const int nw = qb * 4 + (wid >> 1);
    const int m_lo = (qb * 4 - 8) > 0 ? (qb * 4 - 8) : 0, m_hi = qb * 4 + 3;
    bf16x8 qf[2][4];
#pragma unroll
    for (int qt = 0; qt < 2; ++qt)
#pragma unroll
        for (int ks = 0; ks < 4; ++ks) qf[qt][ks] = *(const bf16x8*)(qkvn + (size_t)(t0 + 32 * wid + 16 * qt + fr) * 8192 + h * 128 + 32 * ks + 8 * fq);
    f32x4 oacc[8][2];
#pragma unroll
    for (int dt = 0; dt < 8; ++dt) { oacc[dt][0] = (f32x4){0.f, 0.f, 0.f, 0.f}; oacc[dt][1] = (f32x4){0.f, 0.f, 0.f, 0.f}; }
    float mrow[2] = {-1.0e30f, -1.0e30f}, lrow[2] = {0.f, 0.f};
    u32x4 kr[2], vr[2];
    const bf16* kbase = kT + (size_t)(b * 16 + h) * 32 * 8192;
    const bf16* vbase = vT + (size_t)(b * 16 + h) * 32 * 8192;
#define ATT_LOAD(m) do { _Pragma("unroll") for (int i = 0; i < 2; ++i) { const int id = tid + 512 * i; \
        kr[i] = *(const u32x4*)(kbase + (size_t)(m) * 8192 + id * 8); \
        vr[i] = *(const u32x4*)(vbase + (size_t)(m) * 8192 + id * 8); } } while (0)
#define ATT_WRITE(buf) do { _Pragma("unroll") for (int i = 0; i < 2; ++i) { const int id = tid + 512 * i; const int kr_ = id >> 4, kc_ = id & 15; \
        *(LAS u32x4*)(lds + ATT_K0 + (buf) * ATT_KB + kr_ * 256 + ((kc_ ^ (kr_ & 15)) << 4)) = kr[i]; \
        *(LAS u32x4*)(lds + ATT_V0 + (buf) * ATT_VB + (id >> 3) * ATT_VROW + (id & 7) * 16) = vr[i]; } } while (0)
    ATT_LOAD(m_lo); ATT_WRITE(0);
    __syncthreads();
    const float SCALE = 0.08838834764831845f * LOG2E;
    for (int m = m_lo; m <= m_hi; ++m) {
        const int cur = (m - m_lo) & 1;
        if (m < m_hi) ATT_LOAD(m + 1);
        if (m >= nw - 8 && m <= nw) {
            const LAS unsigned char* Kb = lds + ATT_K0 + cur * ATT_KB; const LAS unsigned char* Vb = lds + ATT_V0 + cur * ATT_VB;
            f32x4 sacc[4][2];
#pragma unroll
            for (int kt = 0; kt < 4; ++kt) { sacc[kt][0] = (f32x4){0.f, 0.f, 0.f, 0.f}; sacc[kt][1] = (f32x4){0.f, 0.f, 0.f, 0.f}; }
            __builtin_amdgcn_s_setprio(1);
#pragma unroll
            for (int ks = 0; ks < 4; ++ks)
#pragma unroll
                for (int kt = 0; kt < 4; ++kt) { const bf16x8 kf = *(const LAS bf16x8*)(Kb + (16 * kt + fr) * 256 + (((4 * ks + fq) ^ fr) << 4));
                    sacc[kt][0] = __builtin_amdgcn_mfma_f32_16x16x32_bf16(kf, qf[0][ks], sacc[kt][0], 0, 0, 0);
                    sacc[kt][1] = __builtin_amdgcn_mfma_f32_16x16x32_bf16(kf, qf[1][ks], sacc[kt][1], 0, 0, 0);
                    if (kt == 3) __builtin_amdgcn_sched_barrier(0); }
            __builtin_amdgcn_s_setprio(0);
            const int dc = nw - m;
            bf16x8 pf[2][2];
#pragma unroll
            for (int qt = 0; qt < 2; ++qt) {
                const int qi = 32 * (wid & 1) + 16 * qt + fr;
                float mx = -3.0e38f;
                const LAS float* bp = biasl + (64 * dc + qi + 256 - 4 * fq - 63);
#pragma unroll
                for (int kt = 0; kt < 4; ++kt)
#pragma unroll
                    for (int r = 0; r < 4; ++r) { const float v = sacc[kt][qt][r] * SCALE + bp[63 - 16 * kt - r]; sacc[kt][qt][r] = v; mx = fmaxf(mx, v); }
                mx = fmaxf(mx, __shfl_xor(mx, 16)); mx = fmaxf(mx, __shfl_xor(mx, 32));
                if (__any(mx > mrow[qt] + 8.0f)) {
                    const float mnew = fmaxf(mrow[qt], mx), alpha = __builtin_amdgcn_exp2f(mrow[qt] - mnew);
                    mrow[qt] = mnew; lrow[qt] = lrow[qt] * alpha;
#pragma unroll
                    for (int dt = 0; dt < 8; ++dt) oacc[dt][qt] = oacc[dt][qt] * alpha;
                }
                const float mcur = mrow[qt];
                float ls = 0.f;
#pragma unroll
                for (int kt = 0; kt < 4; ++kt)
#pragma unroll
                    for (int r = 0; r < 4; ++r) { const float p = __builtin_amdgcn_exp2f(sacc[kt][qt][r] - mcur); sacc[kt][qt][r] = p; ls += p; }
                lrow[qt] += ls;
#pragma unroll
                for (int s = 0; s < 2; ++s) { u32x4 w; w.x = cvt_pk_bf16(sacc[2 * s][qt][0], sacc[2 * s][qt][1]); w.y = cvt_pk_bf16(sacc[2 * s][qt][2], sacc[2 * s][qt][3]);
                    w.z = cvt_pk_bf16(sacc[2 * s + 1][qt][0], sacc[2 * s + 1][qt][1]); w.w = cvt_pk_bf16(sacc[2 * s + 1][qt][2], sacc[2 * s + 1][qt][3]); pf[qt][s] = __builtin_bit_cast(bf16x8, w); }
                __builtin_amdgcn_sched_barrier(0);
            }
            __builtin_amdgcn_s_setprio(1);
#pragma unroll
            for (int dt = 0; dt < 8; ++dt)
#pragma unroll
                for (int s = 0; s < 2; ++s) { const bf16x8 vf = *(const LAS bf16x8*)(Vb + (16 * dt + fr) * ATT_VROW + 64 * s + 16 * fq);
                    oacc[dt][0] = __builtin_amdgcn_mfma_f32_16x16x32_bf16(vf, pf[0][s], oacc[dt][0], 0, 0, 0);
                    oacc[dt][1] = __builtin_amdgcn_mfma_f32_16x16x32_bf16(vf, pf[1][s], oacc[dt][1], 0, 0, 0);
                    if ((dt & 3) == 3 && s == 1) __builtin_amdgcn_sched_barrier(0); }
            __builtin_amdgcn_s_setprio(0);
        }
        if (m < m_hi) ATT_WRITE(cur ^ 1);
        __syncthreads();
    }
#undef ATT_LOAD
#undef ATT_WRITE
#pragma unroll
    for (int qt = 0; qt < 2; ++qt) {
        float l = lrow[qt]; l += __shfl_xor(l, 16); l += __shfl_xor(l, 32);
        const float inv = 1.0f / l;
        unsigned char* orow = mix + (size_t)(t0 + 32 * wid + 16 * qt + fr) * 4096 + h * 128 + 4 * fq;
        const float inv128 = 128.0f * inv;
#pragma unroll
        for (int dt = 0; dt < 8; ++dt) { const f32x4 o = oacc[dt][qt] * inv128; *(unsigned*)(orow + 16 * dt) = pk4_fp8(o[0], o[1], o[2], o[3]); }
    }
}

__device__ __forceinline__ void ret_unit(LAS unsigned char* lds, const bf16* __restrict__ qkvn, const bf16* __restrict__ kT, const bf16* __restrict__ vT, unsigned char* __restrict__ mix, const float* __restrict__ gn_w,
                                         int b, int h, int qb2, int tid, int wid, int lane) {
    asm volatile("" : "+v"(tid), "+v"(lane), "+s"(wid));
    const int fr = lane & 15, fq = lane >> 4;
    __syncthreads();
    const int t0 = b * SEQ + qb2 * 128;
    const int nw = qb2 * 2 + (wid >> 2);
    const int m_hi = qb2 * 2 + 1;
    float lg2g; { const float x = __builtin_amdgcn_exp2f((float)(-5 - h)); lg2g = -(x * (1.0f + x * (0.5f + x * (0.33333334f + x * (0.25f + x * (0.2f + x * 0.16666667f)))))) * LOG2E; }
    bf16x8 qf[4];
#pragma unroll
    for (int ks = 0; ks < 4; ++ks) qf[ks] = *(const bf16x8*)(qkvn + (size_t)(t0 + 16 * wid + fr) * 8192 + 4096 + h * 128 + 32 * ks + 8 * fq);
    f32x4 oacc[16];
#pragma unroll
    for (int dt = 0; dt < 16; ++dt) oacc[dt] = (f32x4){0.f, 0.f, 0.f, 0.f};
    u32x4 kr[2], vr[4];
    const bf16* kbase = kT + (size_t)(b * 8 + h) * 32 * 8192;
    const bf16* vbase = vT + (size_t)(b * 8 + h) * 32 * 16384;
#define RET_LOAD(m) do { _Pragma("unroll") for (int i = 0; i < 2; ++i) { const int id = tid + 512 * i; kr[i] = *(const u32x4*)(kbase + (size_t)(m) * 8192 + id * 8); } \
        _Pragma("unroll") for (int i = 0; i < 4; ++i) { const int id = tid + 512 * i; vr[i] = *(const u32x4*)(vbase + (size_t)(m) * 16384 + id * 8); } } while (0)
#define RET_W1(buf, i) do { if ((i) < 2) *(LAS u32x4*)(lds + ATT_K0 + (buf) * ATT_KB + kw0 + (i) * 8192) = kr[(i) & 1];        \
        else *(LAS u32x4*)(lds + ATT_V0 + (buf) * ATT_VB + vw0 + ((i) - 2) * 64 * ATT_VROW) = vr[((i) - 2) & 3]; } while (0)
#define RET_WRITE(buf) do { RET_W1(buf, 0); RET_W1(buf, 1); RET_W1(buf, 2); RET_W1(buf, 3); RET_W1(buf, 4); RET_W1(buf, 5); } while (0)
#define RET_BAR() do { asm volatile("s_waitcnt lgkmcnt(0)" ::: "memory"); __builtin_amdgcn_s_barrier(); asm volatile("" ::: "memory"); } while (0)
    const int kw0 = (tid >> 4) * 256 + (((tid & 15) ^ ((tid >> 4) & 15)) << 4), vw0 = (tid >> 3) * ATT_VROW + (tid & 7) * 16;
    RET_LOAD(0); RET_WRITE(0); RET_LOAD(1);
    RET_BAR();
    const int qi = 16 * (wid & 3) + fr;
    const float rowf = 0.08838834764831845f * __builtin_amdgcn_exp2f(lg2g * (float)qi);
    float colr[4], colk[4];
#pragma unroll
    for (int r = 0; r < 4; ++r) { colr[r] = __builtin_amdgcn_exp2f(-lg2g * (float)(4 * fq + r));
        colk[r] = __builtin_bit_cast(float, __builtin_amdgcn_readfirstlane(__builtin_bit_cast(int, __builtin_amdgcn_exp2f(-lg2g * (float)(16 * r))))); }
#define RET_SB() __builtin_amdgcn_sched_barrier(0)
#define RET_LDK(F, ks) do { _Pragma("unroll") for (int kt = 0; kt < 4; ++kt) F[kt] = *(const LAS bf16x8*)(Kb + (16 * kt + fr) * 256 + (((4 * (ks) + fq) ^ fr) << 4)); } while (0)
#define RET_LDV(F, g) do { _Pragma("unroll") for (int e = 0; e < 4; ++e) F[e] = *(const LAS bf16x8*)(Vb + (16 * (2 * (g) + (e >> 1)) + fr) * ATT_VROW + 64 * (e & 1) + 16 * fq); } while (0)
#define RET_MMK(F, ks) do { _Pragma("unroll") for (int kt = 0; kt < 4; ++kt) sacc[kt] = __builtin_amdgcn_mfma_f32_16x16x32_bf16(F[kt], qf[ks], sacc[kt], 0, 0, 0); } while (0)
#define RET_MMV(F, g) do { _Pragma("unroll") for (int e = 0; e < 4; ++e) oacc[2 * (g) + (e >> 1)] = __builtin_amdgcn_mfma_f32_16x16x32_bf16(F[e], pf[e & 1], oacc[2 * (g) + (e >> 1)], 0, 0, 0); } while (0)
#define RET_COMPUTE(mm, buf, ml) do { const int m_ = (mm); if (m_ <= nw) { \
            const LAS unsigned char* Kb = lds + ATT_K0 + (m_ & 1) * ATT_KB; const LAS unsigned char* Vb = lds + ATT_V0 + (m_ & 1) * ATT_VB; \
            f32x4 sacc[4]; bf16x8 fa[4], fb[4]; \
            _Pragma("unroll") for (int kt = 0; kt < 4; ++kt) sacc[kt] = (f32x4){0.f, 0.f, 0.f, 0.f}; \
            RET_LDK(fa, 0); RET_SB(); \
            RET_LDK(fb, 1); RET_SB(); RET_MMK(fa, 0); RET_SB(); \
            RET_LDK(fa, 2); RET_SB(); RET_MMK(fb, 1); RET_SB(); \
            RET_LDK(fb, 3); RET_SB(); RET_MMK(fa, 2); RET_SB(); \
            RET_LDV(fa, 0); RET_SB(); RET_MMK(fb, 3); RET_SB(); \
            RET_LDV(fb, 1); RET_SB(); \
            if (m_ < nw) { const float rs_ = rowf * __builtin_amdgcn_exp2f(lg2g * (float)(64 * (nw - m_))); \
                _Pragma("unroll") for (int kt = 0; kt < 4; ++kt) { const float rk_ = rs_ * colk[kt]; _Pragma("unroll") for (int r = 0; r < 4; ++r) sacc[kt][r] = sacc[kt][r] * (rk_ * colr[r]); } \
            } else { \
                _Pragma("unroll") for (int kt = 0; kt < 4; ++kt) _Pragma("unroll") for (int r = 0; r < 4; ++r) { int dist = qi - (16 * kt + 4 * fq + r); dist = dist < 0 ? -dist : dist; \
                        sacc[kt][r] = sacc[kt][r] * (0.08838834764831845f * __builtin_amdgcn_exp2f(lg2g * (float)dist)); } } \
            bf16x8 pf[2]; \
            _Pragma("unroll") for (int s = 0; s < 2; ++s) { u32x4 w; w.x = cvt_pk_bf16(sacc[2 * s][0], sacc[2 * s][1]); w.y = cvt_pk_bf16(sacc[2 * s][2], sacc[2 * s][3]); \
                w.z = cvt_pk_bf16(sacc[2 * s + 1][0], sacc[2 * s + 1][1]); w.w = cvt_pk_bf16(sacc[2 * s + 1][2], sacc[2 * s + 1][3]); pf[s] = __builtin_bit_cast(bf16x8, w); } \
            RET_SB(); \
            RET_MMV(fa, 0); RET_SB(); RET_LDV(fa, 2); RET_SB(); \
            RET_MMV(fb, 1); RET_SB(); RET_LDV(fb, 3); RET_W1(buf, 0); RET_SB(); \
            RET_MMV(fa, 2); RET_SB(); RET_LDV(fa, 4); RET_W1(buf, 1); RET_SB(); \
            RET_MMV(fb, 3); RET_SB(); RET_LDV(fb, 5); RET_W1(buf, 2); RET_SB(); \
            RET_MMV(fa, 4); RET_SB(); RET_LDV(fa, 6); RET_W1(buf, 3); RET_SB(); \
            RET_MMV(fb, 5); RET_SB(); RET_LDV(fb, 7); RET_W1(buf, 4); RET_SB(); \
            RET_MMV(fa, 6); RET_SB(); RET_W1(buf, 5); RET_SB(); RET_MMV(fb, 7); RET_SB(); \
        } else { RET_WRITE(buf); } RET_LOAD(ml); } while (0)
    for (int m = 0; m <= m_hi; m += 2) {
        { const int ml = m + 2 <= m_hi ? m + 2 : m_hi; RET_COMPUTE(m, 1, ml); }
        RET_BAR();
        { const int ml = m + 3 <= m_hi ? m + 3 : m_hi; RET_COMPUTE(m + 1, 0, ml); }
        RET_BAR();
    }
#undef RET_LOAD
#undef RET_WRITE
#undef RET_COMPUTE
#undef RET_W1
#undef RET_SB
#undef RET_LDK
#undef RET_LDV
#undef RET_MMK
#undef RET_MMV
#undef RET_BAR
    float s1 = 0.f;
#pragma unroll
    for (int dt = 0; dt < 16; ++dt) s1 += (oacc[dt][0] + oacc[dt][1]) + (oacc[dt][2] + oacc[dt][3]);
    s1 += __shfl_xor(s1, 16); s1 += __shfl_xor(s1, 32);
    const float mu = s1 * (1.0f / 256.0f);
    float s2 = 0.f;
#pragma unroll
    for (int dt = 0; dt < 16; ++dt) { const f32x4 d = oacc[dt] - mu; s2 += (d[0] * d[0] + d[1] * d[1]) + (d[2] * d[2] + d[3] * d[3]); }
    s2 += __shfl_xor(s2, 16); s2 += __shfl_xor(s2, 32);
    const float rstd = 1.0f / sqrtf(s2 * (1.0f / 256.0f) + EPS);
    const size_t trow = (size_t)(t0 + 16 * wid + fr);
    const bf16* grow = qkvn + trow * 8192 + 6144 + h * 256 + 4 * fq;
    unsigned char* orow = mix + trow * 4096 + 2048 + h * 256 + 4 * fq;
    const float* gw = gn_w + h * 256 + 4 * fq;
#pragma unroll
    for (int dt = 0; dt < 16; ++dt) {
        const u32x2 gg = *(const u32x2*)(grow + 16 * dt); const f32x4 w = *(const f32x4*)(gw + 16 * dt);
        const float g0 = bf_lo(gg.x), g1 = bf_hi(gg.x), g2 = bf_lo(gg.y), g3 = bf_hi(gg.y);
        const f32x4 yn = (oacc[dt] - mu) * rstd * w;
        const float o0 = yn[0] * g0 / (1.0f + __builtin_amdgcn_exp2f(-g0 * LOG2E)), o1 = yn[1] * g1 / (1.0f + __builtin_amdgcn_exp2f(-g1 * LOG2E));
        const float o2 = yn[2] * g2 / (1.0f + __builtin_amdgcn_exp2f(-g2 * LOG2E)), o3 = yn[3] * g3 / (1.0f + __builtin_amdgcn_exp2f(-g3 * LOG2E));
        *(unsigned*)(orow + 16 * dt) = pk4_fp8(16.f * o0, 16.f * o1, 16.f * o2, 16.f * o3);
        if ((dt & 3) == 3) asm volatile("" ::: "memory");
    }
}

__device__ __forceinline__ unsigned key_pack(float v, int k) { unsigned u = __builtin_bit_cast(unsigned, v); u = (u & 0x80000000u) ? ~u : (u | 0x80000000u); return (u & ~127u) | (unsigned)(127 - k); }
__device__ __forceinline__ float key_val(unsigned p) { unsigned u = p & ~127u; u = (u & 0x80000000u) ? (u & 0x7fffffffu) : ~u; return __builtin_bit_cast(float, u); }
__device__ __forceinline__ float rdl_f(float v, int l) { return __builtin_bit_cast(float, __builtin_amdgcn_readlane(__builtin_bit_cast(int, v), l)); }

template <int CTRL> __device__ __forceinline__ unsigned dpp_u(unsigned v) { return (unsigned)__builtin_amdgcn_update_dpp((int)v, (int)v, CTRL, 0xf, 0xf, false); }
__device__ __forceinline__ unsigned row_max_u(unsigned v) { unsigned t;
    t = dpp_u<0xB1>(v); v = t > v ? t : v; t = dpp_u<0x4E>(v); v = t > v ? t : v; t = dpp_u<0x141>(v); v = t > v ? t : v; t = dpp_u<0x140>(v); v = t > v ? t : v; return v; }
__device__ __forceinline__ float row_sum_f(float v) {
    v += __builtin_bit_cast(float, dpp_u<0xB1>(__builtin_bit_cast(unsigned, v))); v += __builtin_bit_cast(float, dpp_u<0x4E>(__builtin_bit_cast(unsigned, v)));
    v += __builtin_bit_cast(float, dpp_u<0x141>(__builtin_bit_cast(unsigned, v))); v += __builtin_bit_cast(float, dpp_u<0x140>(__builtin_bit_cast(unsigned, v))); return v; }
#define TK_CE(a, b) do { const unsigned hi_ = (a) > (b) ? (a) : (b), lo_ = (a) > (b) ? (b) : (a); (a) = hi_; (b) = lo_; } while (0)
__device__ __forceinline__ unsigned ord_u(float v) { const unsigned u = __builtin_bit_cast(unsigned, v); return (u & 0x80000000u) ? ~u : (u | 0x80000000u); }
__device__ __forceinline__ float ord_f(unsigned u) { return __builtin_bit_cast(float, (u & 0x80000000u) ? (u & 0x7fffffffu) : ~u); }

__device__ __forceinline__ void topk_phase(LAS unsigned char* lds, const float* __restrict__ scores, unsigned char* __restrict__ G, int gw, int ngw, int wid, int lane) {
    LAS unsigned* bm = (LAS unsigned*)(lds + wid * 2048);
    LAS unsigned char* lut = (LAS unsigned char*)(lds + 16384 + wid * 64);
#pragma unroll
    for (int i = 0; i < 8; ++i) bm[lane + 64 * i] = 0u;
    { int ci = 0, cj = 0, cnt = 0;
#pragma unroll
      for (int i = 0; i < 16; ++i) { const int n = 16 / (i + 1); if (lane >= cnt && lane < cnt + n) { ci = i; cj = lane - cnt; } cnt += n; }
      lut[lane] = (unsigned char)((ci << 4) | cj); }
    LDS_WAIT();
    const int l = lane & 15, rowbase = lane & 48; const bool oddrow = (lane & 16) != 0;
    int ic[4], jc[4];
#pragma unroll
    for (int sidx = 0; sidx < 4; ++sidx) { const int c = 4 * l + sidx; const unsigned ij = lut[c < 50 ? c : 0]; ic[sidx] = rowbase + (int)(ij >> 4); jc[sidx] = rowbase + (int)(ij & 15u); }
    for (int t = gw; t < T; t += ngw) {
        unsigned char* Grow = G + (size_t)t * NEXP;
        unsigned res[4];
        {
            unsigned k[4][8];
            const f32x4* sr = (const f32x4*)(scores + (size_t)t * 2048) + lane * 2;
#pragma unroll
            for (int p = 0; p < 4; ++p) { const f32x4 a = sr[p * 128], b = sr[p * 128 + 1];
#pragma unroll
                for (int e = 0; e < 4; ++e) { k[p][e] = (ord_u(a[e]) & ~127u) | (unsigned)(127 - (8 * l + e)); k[p][4 + e] = (ord_u(b[e]) & ~127u) | (unsigned)(127 - (8 * l + 4 + e)); }
                TK_CE(k[p][0], k[p][1]); TK_CE(k[p][2], k[p][3]); TK_CE(k[p][4], k[p][5]); TK_CE(k[p][6], k[p][7]);
                TK_CE(k[p][0], k[p][2]); TK_CE(k[p][1], k[p][3]); TK_CE(k[p][4], k[p][6]); TK_CE(k[p][5], k[p][7]);
                TK_CE(k[p][1], k[p][2]); TK_CE(k[p][5], k[p][6]);
                TK_CE(k[p][0], k[p][4]); TK_CE(k[p][1], k[p][5]); TK_CE(k[p][2], k[p][6]); TK_CE(k[p][3], k[p][7]);
                TK_CE(k[p][2], k[p][4]); TK_CE(k[p][3], k[p][5]);
                TK_CE(k[p][1], k[p][2]); TK_CE(k[p][3], k[p][4]); TK_CE(k[p][5], k[p][6]);
                res[p] = 0u; }
            for (int r = 0; r < 16; ++r) {
#pragma unroll
                for (int p = 0; p < 4; ++p) { const unsigned mm = row_max_u(k[p][0]); res[p] = (l == r) ? mm : res[p]; const bool pop = k[p][0] == mm;
#pragma unroll
                    for (int e = 0; e < 7; ++e) k[p][e] = pop ? k[p][e + 1] : k[p][e];
                    k[p][7] = pop ? 0u : k[p][7]; }
            }
        }
        int ee[2]; float gg[2]; bool dup[2];
#pragma unroll
        for (int q = 0; q < 2; ++q) {
            const unsigned tx = (unsigned)__shfl((int)res[2 * q + 1], lane - 16), ty = (unsigned)__shfl((int)res[2 * q], lane + 16);
            const unsigned X = oddrow ? tx : res[2 * q], Y = oddrow ? res[2 * q + 1] : ty;
            const float xv = ord_f(X & ~127u), yv = ord_f(Y & ~127u);
            unsigned ck[4];
#pragma unroll
            for (int sidx = 0; sidx < 4; ++sidx) { const float sum = __shfl(xv, ic[sidx]) + __shfl(yv, jc[sidx]); const int c = 4 * l + sidx;
                ck[sidx] = (c < 50) ? ((ord_u(sum) & ~63u) | (unsigned)(63 - c)) : 0u; }
            TK_CE(ck[0], ck[1]); TK_CE(ck[2], ck[3]); TK_CE(ck[0], ck[2]); TK_CE(ck[1], ck[3]); TK_CE(ck[1], ck[2]);
            unsigned win = 0u;
            for (int r = 0; r < 16; ++r) { const unsigned mm = row_max_u(ck[0]); win = (l == r) ? mm : win; const bool pop = ck[0] == mm;
                ck[0] = pop ? ck[1] : ck[0]; ck[1] = pop ? ck[2] : ck[1]; ck[2] = pop ? ck[3] : ck[2]; ck[3] = pop ? 0u : ck[3]; }
            const unsigned ij = lut[63 - (int)(win & 63u)];
            const int ia = 127 - (int)((unsigned)__shfl((int)X, rowbase + (int)(ij >> 4)) & 127u), ib = 127 - (int)((unsigned)__shfl((int)Y, rowbase + (int)(ij & 15u)) & 127u);
            const float val = ord_f(win & ~63u), vmax = __shfl(val, rowbase);
            const float ex = __builtin_amdgcn_exp2f((val - vmax) * LOG2E);
            gg[q] = ex / row_sum_f(ex); ee[q] = ia * 128 + ib; dup[q] = false;
        }
#pragma unroll
        for (int q = 0; q < 2; ++q) { const unsigned bit = 1u << (ee[q] & 31); const unsigned old = __hip_atomic_fetch_or(&bm[ee[q] >> 5], bit, __ATOMIC_RELAXED, __HIP_MEMORY_SCOPE_WORKGROUP); dup[q] = (old & bit) != 0u; }
#pragma unroll
        for (int q = 0; q < 2; ++q) { unsigned long long db = __ballot(dup[q]);
            while (db) { const int L = __builtin_ctzll(db); const int es = __builtin_amdgcn_readlane(ee[q], L); const float gs = rdl_f(gg[q], L);
#pragma unroll
                for (int q2 = 0; q2 < 2; ++q2) if (!dup[q2] && ee[q2] == es) gg[q2] += gs;
                db &= db - 1ull; } }
#pragma unroll
        for (int q = 0; q < 2; ++q) bm[ee[q] >> 5] = 0u;
#pragma unroll
        for (int q = 0; q < 2; ++q) if (!dup[q]) { const float qv = fminf(gg[q] * 128.0f + 0.5f, 255.0f);
            const int e_ = ee[q], row_ = t & 255, col_ = e_ & 255;
            const size_t off_ = ((((size_t)((t >> 8) * 64 + (e_ >> 8)) * 8 + (size_t)(((row_ >> 6) & 1) * 4 + ((col_ >> 5) & 3))) * 16 + (size_t)(((row_ >> 7) * 4 + ((row_ >> 4) & 3)) * 2 + (col_ >> 7))) * 64 + (size_t)(((col_ >> 3) & 3) * 16 + (row_ & 15))) * 8 + (size_t)(col_ & 7);
            G[off_] = (unsigned char)(unsigned)qv; }
    }
}
#undef TK_CE

struct Args { const float* in[18]; float* out; unsigned char* ws; int ph_lo, ph_hi, sub, pad; };
constexpr int NPHASE = 13;

__global__ void __launch_bounds__(NWAVES * 64, 2) fwd(Args args) {
    extern __shared__ __attribute__((aligned(16))) unsigned char lds_raw[];
    LAS unsigned char* lds = (LAS unsigned char*)lds_raw;
    volatile LAS unsigned* MISC = (volatile LAS unsigned*)(lds + MISC_OFF);
    const int tid = threadIdx.x, lane = tid & 63, wave = __builtin_amdgcn_readfirstlane(tid >> 6);
    const int G = gridDim.x, bx = blockIdx.x;
    const int vcu = (G % 8 == 0) ? (bx % 8) * (G / 8) + bx / 8 : bx;
    const int gw = vcu * NWAVES + wave, NGW = G * NWAVES;
    unsigned char* ws = args.ws;
    const float* x = args.in[0]; const float* mem = args.in[1]; const float* norm1_w = args.in[2]; const float* w_in = args.in[3]; const float* rel_bias = args.in[4];
    const float* gn_w = args.in[5]; const float* w_out = args.in[6]; const float* norm2_w = args.in[7]; const float* memn_w = args.in[8]; const float* xwq = args.in[9];
    const float* xwkv = args.in[10]; const float* xwo = args.in[11]; const float* norm3_w = args.in[12]; const float* pwq = args.in[13]; const float* psk = args.in[14];
    const float* pu = args.in[15]; const float* pv = args.in[16]; const float* fin_w = args.in[17];
    float* hout = args.out;
    bf16* W_IN = (bf16*)(ws + WS_WIN); bf16* W_OUT = (bf16*)(ws + WS_WOUT); bf16* W_Q = (bf16*)(ws + WS_WQ); bf16* W_KV = (bf16*)(ws + WS_WKV); bf16* W_O = (bf16*)(ws + WS_WO);
    bf16* W_PP = (bf16*)(ws + WS_WPP); bf16* W_U = (bf16*)(ws + WS_U); bf16* W_VT = (bf16*)(ws + WS_VT);
    bf16* XN = (bf16*)(ws + WS_XN); bf16* MEMN = (bf16*)(ws + WS_MEMN); bf16* KVM = (bf16*)(ws + WS_KVM); bf16* WP = (bf16*)(ws + WS_WP); bf16* VPT = (bf16*)(ws + WS_VPT);
    float* RP1 = (float*)(ws + 1 * MiB); float* RP2 = (float*)(ws + 1 * MiB + 512 * 1024);
    bf16* VT_A = (bf16*)(ws + WS_VTA); bf16* VT_R = (bf16*)(ws + WS_VTA + 32 * MiB); bf16* KT_A = (bf16*)(ws + WS_SC); bf16* KT_R = (bf16*)(ws + WS_SC + 32 * MiB);
    unsigned char* W_Q8 = ws + WS_WQ; unsigned char* W_KV8 = ws + WS_WKV; unsigned char* W_O8 = ws + WS_WO; unsigned char* MEMN8 = ws + WS_MEMN;
    unsigned char* KVM8 = ws + WS_KVM; unsigned char* WP8 = ws + WS_WP; unsigned char* VPT8 = ws + WS_VPT; unsigned char* PX8 = ws + WS_PX;
    unsigned char* W_IN8 = ws + WS_WIN;
    bf16* W_INB = (bf16*)(ws + WS_WIN + 40 * MiB);
    unsigned char* U8 = ws + WS_U; unsigned char* VT8 = ws + WS_VT; unsigned char* X8 = ws + WS_X8; unsigned char* P8 = ws + WS_P8;
    bf16* PX = (bf16*)(ws + WS_PX); float* SC = (float*)(ws + WS_SC); bf16* QKVN = (bf16*)(ws + WS_QKVN); bf16* VTA = (bf16*)(ws + WS_VTA); unsigned char* MIX8 = ws + WS_MIX; unsigned char* W_OUT8 = ws + WS_WOUT; bf16* GP = (bf16*)(ws + WS_GP); unsigned char* G8 = ws + WS_GP;

    for (int u = tid; u < (LDS_BYTES - LDSCTL_OFF) / 4; u += NWAVES * 64) ((LAS unsigned*)(lds + LDSCTL_OFF))[u] = 0u;
    __syncthreads();
    const int lo = args.ph_lo, hi = args.ph_hi;
    XcdBarrier bar; bar.bar = (unsigned*)(ws + WS_CTL) + CW_BAR; bar.x = 0; bar.st = nullptr;
    if (hi - lo > 1) bar = xcd_barrier_post((unsigned*)(ws + WS_CTL) + CW_BAR, MISC + 8);
#ifndef PHASE_MASK
#define PHASE_MASK 0xffff
#endif
#define IN(k) (((PHASE_MASK >> (k)) & 1) && lo <= (k) && (k) < hi)
#define SEAM(k) do { if (IN(k) && IN((k) + 1)) xcd_barrier(bar); } while (0)
#define SEAM2(k) do { if (IN(k) && IN((k) + 2)) xcd_barrier(bar); } while (0)

    if (IN(0)) {
        { int t_ = tid; asm volatile("" : "+v"(t_)); LAS f32x4* gl4 = (LAS f32x4*)(lds + PQ_OFF); const f32x4* gw4 = (const f32x4*)norm1_w; gl4[t_] = gw4[t_]; gl4[t_ + 512] = gw4[t_ + 512]; }
        __syncthreads();
        LAS float* scr = (LAS float*)(lds + wave * 16896);
        LAS float* scr8 = (LAS float*)(lds + wave * 16896);
        {
            constexpr int J1 = 32 * 192, J1B = 32 * 128, J2 = 32 * 128, J3 = 32 * 256, J4 = 32 * 128, J5 = 128 * 128, NJ = J1 + J1B + J2 + J3 + J4 + J5;
            for (int it = gw; it < NJ; it += NGW) {
                int r = it;
                if (r < J1) { const int n0 = (r % 192) * 32; transpose_item8b(w_in, 4096, 12288, W_IN8, (r / 192) * 128, n0, n0, scr8, lane, 1024.0f); continue; } r -= J1;
                if (r < J1B) { const int n0 = 8192 + (r % 128) * 32; transpose_item8b(w_in, 4096, 12288, W_IN8, (r / 128) * 128, n0, n0 - 2048, scr8, lane, 1024.0f); continue; } r -= J1B;

                if (r < J2) { const int k0 = (r / 128) * 128, n0 = (r % 128) * 32; transpose_item8b(w_out, 4096, 4096, W_OUT8, k0, n0, n0, scr8, lane, k0 < 2048 ? 128.0f : 1024.0f); continue; } r -= J2;
                if (r < J3) { const int n0 = (r % 256) * 32; transpose_item8b(xwkv, 4096, 8192, W_KV8, (r / 256) * 128, n0, n0, scr8, lane, 1024.0f); continue; } r -= J3;
                if (r < J4) { const int n0 = (r % 128) * 32; transpose_item8b(xwo, 4096, 4096, W_O8, (r / 128) * 128, n0, n0, scr8, lane, 1024.0f); continue; } r -= J4;
                { const int n0 = (r % 128) * 32; transpose_item8b(pv, 16384, 4096, VT8, (r / 128) * 128, n0, n0, scr8, lane, 32.0f); }
            }
        }
        {
            for (int it = gw; it < 64 * 32; it += NGW) { const int kb = it / 32, n0 = 6144 + (it % 32) * 64;
                int dr = n0 - 6144;
                { const int t_old = (dr >> 6) & 3; dr = (dr & ~255) + 64 * (2 * (t_old & 1) + (t_old >> 1)); }
                transpose_item(w_in, 4096, 12288, W_INB, kb * 64, n0, dr, scr, lane); }
        }
        for (int it = gw; it < 8192; it += NGW) convert_item8(xwq, W_Q8, (size_t)it, lane, 1024.0f * norm2_w[it >> 1], nullptr);
        for (int it = gw; it < 32768; it += NGW) convert_item8(pu, U8, (size_t)it, lane, 1024.0f, norm3_w);
        rms_rows_bf16_fp8(x, (const LAS float*)(lds + PQ_OFF), XN, X8, gw, NGW, T, lane);
        for (int m = gw; m < TM; m += NGW) rms_row_fp8(mem + (size_t)m * D, memn_w, MEMN8 + (size_t)m * D, lane);
        for (int it = gw; it < 4096; it += NGW) wpp_item(pwq, psk, norm3_w, W_PP, it, lane);
    }
    SEAM(0);
    if (IN(1)) {
        { pg8::Gemm g{XN, W_INB, 4096, 4096, 4096}; pg8::SchedPlain S; S.init(32, 8, G, bx); pg8::EpiBf16Rot E{QKVN + 4096, 8192, KT_R};
          pg8::gemm_phase<pg8::EpiBf16Rot, pg8::SchedPlain>(lds + RING_OFF, g, S, E); }
        { pg8::Gemm g{(const bf16*)ws, (const bf16*)ws, 2048, 2048, 2048};
          pg8::SchedP1 S{G, bx, WS_X8, WS_WIN, WS_MEMN, WS_WKV};
          pg8::EpiP1 E{pg8::EpiBf16QK{QKVN, 8192, KT_A}, pg8::EpiBf16S{QKVN + 4096 + 2048, 8192, 1.0f}, pg8::EpiBf16VT{VT_A, 7, 16}, pg8::EpiBf16VT{VT_R, 8, 8}, pg8::EpiFp8S{KVM8, 8192, 16.0f}};
          pg8::gemm_phase<pg8::EpiP1, pg8::SchedP1, true, 113>(lds + RING_OFF, g, S, E); }
        if (bx >= 128 || G < 256) {
            const int nz = (G < 256) ? G : G - 128, zi = (G < 256) ? bx : bx - 128;
            u32x4* gz = (u32x4*)P8; const size_t n16 = (size_t)T * NEXP / 16;
            for (size_t i = (size_t)zi * 512 + tid; i < n16; i += (size_t)nz * 512) gz[i] = (u32x4){0u, 0u, 0u, 0u};
        }
    }
    SEAM(1);
    if (IN(2)) {
        if (args.sub & 1) {
        { pg8::Gemm g{(const bf16*)KVM8, (const bf16*)W_Q8, 4096, 2048, 512}; pg8::SchedWp S; S.init(16, 16, G, bx); S.es = 1; pg8::EpiFp8S E{WP8, 4096, 32.0f};
          pg8::gemm_phase<pg8::EpiFp8S, pg8::SchedWp, true, 113>(lds + RING_OFF, g, S, E); }
        { pg8::Gemm g{(const bf16*)W_O8, (const bf16*)KVM8, 2048, 4096, 512}; pg8::SchedVp S; S.init(16, 16, G, bx); S.es = 1; pg8::EpiFp8S E{VPT8, 1024, 32.0f};
          pg8::gemm_phase<pg8::EpiFp8S, pg8::SchedVp, true, 113>(lds + RING_OFF, g, S, E); }
        }
        if (args.sub & 2)
        for (int p = vcu; p < 256; p += G) { const int bh = p >> 2, k = p & 3;
            attn_unit(lds, QKVN, KT_A, VT_A, MIX8, rel_bias, bh >> 4, bh & 15, 7 - k, tid, wave, lane);
            attn_unit(lds, QKVN, KT_A, VT_A, MIX8, rel_bias, bh >> 4, bh & 15, k, tid, wave, lane); }
        if (args.sub & 4)
        for (int p = vcu; p < 256; p += G) { const int bh = p >> 3, j = p & 7;
            ret_unit(lds, QKVN, KT_R, VT_R, MIX8, gn_w, bh >> 3, bh & 7, 15 - j, tid, wave, lane);
            ret_unit(lds, QKVN, KT_R, VT_R, MIX8, gn_w, bh >> 3, bh & 7, j, tid, wave, lane); }
        __syncthreads();
    }
    SEAM(2);
    if (IN(3)) {
        pg8::Gemm g{(const bf16*)MIX8, (const bf16*)W_OUT8, 2048, 2048, 2048}; pg8::SchedPlain S; S.init(32, 16, G, bx); pg8::EpiResNorm<false> E{x, XN, X8, RP1, lds + XCH_OFF};
        pg8::gemm_phase<pg8::EpiResNorm<false>, pg8::SchedPlain, true, 113>(lds + RING_OFF, g, S, E);
    }
    SEAM2(3);
    if (IN(5)) {
        pg8::Gemm g{(const bf16*)X8, (const bf16*)WP8, 2048, 2048, 2048}; pg8::SchedS S; S.init(32, 4, G, bx); S.es = 1; pg8::EpiSoftmax E{PX8, 1024, lds + XCH_OFF, 0.03125f * LOG2E, RP1, lds + RS_OFF};
        pg8::gemm_phase<pg8::EpiSoftmax, pg8::SchedS, true, 118>(lds + RING_OFF, g, S, E);
        if (bx >= 128 || G < 256) {
            const int nz = (G < 256) ? G : G - 128, zi = (G < 256) ? bx : bx - 128;
            u32x4* gz = (u32x4*)G8; const size_t n16 = (size_t)T * NEXP / 16;
            for (size_t i = (size_t)zi * 512 + tid; i < n16; i += (size_t)nz * 512) gz[i] = (u32x4){0u, 0u, 0u, 0u};
        }
    }
    SEAM(5);
    if (IN(6)) {
        pg8::Gemm g{(const bf16*)PX8, (const bf16*)VPT8, 512, 512, 512}; pg8::SchedO S; S.init(32, 16, G, bx); S.es = 1; pg8::EpiResNorm<true> E{XN, XN, X8, RP2, lds + XCH_OFF};
        pg8::gemm_phase<pg8::EpiResNorm<true>, pg8::SchedO, true, 114>(lds + RING_OFF, g, S, E);
    }
    SEAM2(6);
    if (IN(8)) {
        pg8::Gemm g{XN, W_PP, 4096, 4096, 4096}; pg8::SchedPlain S; S.init(32, 8, G, bx); pg8::EpiF32 E{SC, 2048, RP2, lds + RS_OFF};
        pg8::gemm_phase<pg8::EpiF32, pg8::SchedPlain>(lds + RING_OFF, g, S, E);
    }
    SEAM(8);
    if (IN(9)) { topk_phase(lds, SC, G8, gw, NGW, wave, lane); }
    SEAM(9);
    if (IN(10)) {
        pg8::Gemm g{(const bf16*)X8, (const bf16*)U8, 2048, 2048, 2048}; pg8::SchedPlain S; S.init(32, 64, G, bx); pg8::EpiPeer8 E{G8, P8, NEXP, RP2, lds + RS_OFF, lds + PQ_OFF};
        pg8::gemm_phase<pg8::EpiPeer8, pg8::SchedPlain, true, 113>(lds + RING_OFF, g, S, E);
    }
    SEAM(10);
    if (IN(11)) {
        pg8::Gemm g{(const bf16*)P8, (const bf16*)VT8, NEXP / 2, NEXP / 2, NEXP / 2}; pg8::SchedPlain S; S.init(32, 16, G, bx); pg8::EpiResBf16 E{XN};
        pg8::gemm_phase<pg8::EpiResBf16, pg8::SchedPlain, true, 117>(lds + RING_OFF, g, S, E);
    }
    SEAM(11);
#ifdef DBG_CHECK
    if (IN(13)) {
        for (int t = gw; t < T; t += NGW) {
            float sum = 0.f; int bad = 0;
#if DBG_CHECK == 1
            const u32x4* gr = (const u32x4*)(GP + (size_t)t * NEXP);
            for (int i = 0; i < 32; ++i) { const u32x4 w = gr[i * 64 + lane];
                for (int e = 0; e < 4; ++e) { const float a = bf_lo(w[e]), b = bf_hi(w[e]); if (!(fabsf(a) < 1e30f) || !(fabsf(b) < 1e30f)) bad = 1; sum += a + b; } }
            sum = wave_sum(sum); bad = __any(bad) ? 1 : 0;
            if (!(sum > 7.9f && sum < 8.1f)) bad = 1;
#elif DBG_CHECK == 3 || DBG_CHECK == 4
            const u32x4* gr = (DBG_CHECK == 3) ? (const u32x4*)(XN + (size_t)t * D) : (const u32x4*)(W_PP + (size_t)(t & 2047) * D);
            for (int i = 0; i < 8; ++i) { const u32x4 w = gr[i * 64 + lane];
                for (int e = 0; e < 4; ++e) { const float a = bf_lo(w[e]), b = bf_hi(w[e]); if (!(fabsf(a) < 1e30f) || !(fabsf(b) < 1e30f)) bad = 1; sum += a * a + b * b; } }
            sum = wave_sum(sum); bad = __any(bad) ? 1 : 0;
            if (DBG_CHECK == 3) { if (!(sum > 2048.f && sum < 8192.f)) bad = 1; } else { if (!(sum > 0.5f && sum < 2.0f)) bad = 1; }
#else
            const f32x4* sr4 = (const f32x4*)(SC + (size_t)t * 2048);
            for (int i = 0; i < 8; ++i) { const f32x4 w = sr4[i * 64 + lane]; for (int e = 0; e < 4; ++e) { if (!(fabsf(w[e]) < 1e4f)) bad = 1; sum += w[e] * w[e]; } }
            sum = wave_sum(sum); bad = __any(bad) ? 1 : 0;
            if (!(sum > 2048.f * 0.5f && sum < 2048.f * 2.0f)) bad = 1;
#endif
            if (bad) { f32x4* hr = (f32x4*)(hout + (size_t)t * D); for (int j = 0; j < 16; ++j) hr[64 * j + lane] = (f32x4){0.f, 0.f, 0.f, 0.f}; }
        }
    }
#endif
    if (IN(12)) {
        { int t_ = tid; asm volatile("" : "+v"(t_)); LAS f32x4* gl4 = (LAS f32x4*)(lds + PQ_OFF); const f32x4* gw4 = (const f32x4*)fin_w; gl4[t_] = gw4[t_]; gl4[t_ + 512] = gw4[t_ + 512]; }
        __syncthreads();
        int ln_ = (int)__builtin_amdgcn_mbcnt_hi(~0u, __builtin_amdgcn_mbcnt_lo(~0u, 0u)); asm volatile("" : "+v"(ln_));
        rms_rows_bf16_to_f32(XN, (const LAS float*)(lds + PQ_OFF), hout, gw, NGW, T, ln_); }
#undef IN
#undef SEAM
}

extern "C" void kernel_launch(void* const* d_in, const int* in_sizes, int n_in, void* d_out, int out_size, void* d_ws, size_t ws_size, hipStream_t stream) {
    static int grid = 0;
    if (grid == 0) {
        if (n_in != 18 || in_sizes[0] != T * D || out_size != T * D || ws_size < WS_END) { fprintf(stderr, "kernel_launch: unexpected shapes (n_in %d, in0 %d, out %d, ws %zu < %zu); nothing launched\n", n_in, n_in > 0 ? in_sizes[0] : -1, out_size, ws_size, (size_t)WS_END); grid = -1; return; }
        int dev = 0, cus = 0, per_cu = 0;
        if (hipGetDevice(&dev) != hipSuccess || hipDeviceGetAttribute(&cus, hipDeviceAttributeMultiprocessorCount, dev) != hipSuccess) { fprintf(stderr, "kernel_launch: device query failed\n"); grid = -1; return; }
        if (hipFuncSetAttribute((const void*)fwd, hipFuncAttributeMaxDynamicSharedMemorySize, LDS_BYTES) != hipSuccess) { fprintf(stderr, "kernel_launch: hipFuncSetAttribute failed\n"); grid = -1; return; }
        if (hipOccupancyMaxActiveBlocksPerMultiprocessor(&per_cu, (const void*)fwd, NWAVES * 64, LDS_BYTES) != hipSuccess || per_cu < 1) fprintf(stderr, "kernel_launch: note: occupancy query reports %d workgroups per CU\n", per_cu);
        (void)hipGetLastError();
        grid = cus;
    }
    if (grid < 0) return;
    if (hipMemsetAsync((char*)d_ws + WS_CTL, 0, CTL_ZERO_BYTES, stream) != hipSuccess) { fprintf(stderr, "kernel_launch: memset failed\n"); return; }
    Args a{};
    for (int i = 0; i < 18; ++i) a.in[i] = (const float*)d_in[i];
    a.out = (float*)d_out; a.ws = (unsigned char*)d_ws;
#if MK_PER_PHASE
    { const int order[] = { PROBE_ORDER }; const int subs[] = { PROBE_SUBS };
      for (unsigned q = 0; q < sizeof(order) / sizeof(int); ++q) { a.ph_lo = order[q]; a.ph_hi = order[q] + 1; a.sub = subs[q]; hipLaunchKernelGGL(fwd, dim3(grid), dim3(NWAVES * 64), LDS_BYTES, stream, a); } }
#else
    a.ph_lo = 0; a.ph_hi = NPHASE; a.sub = 7; hipLaunchKernelGGL(fwd, dim3(grid), dim3(NWAVES * 64), LDS_BYTES, stream, a);
#endif
    const hipError_t le = hipPeekAtLastError();
    if (le != hipSuccess) fprintf(stderr, "kernel_launch: launch failed: %s\n", hipGetErrorName(le));
}
```

```cpp
#include <hip/hip_runtime.h>
#include <cstdio>
#include <cstdint>

#ifndef MK_PER_PHASE
#define MK_PER_PHASE 0
#endif
#ifndef PROBE_ORDER
#define PROBE_ORDER 0,1,2,3,4,5,6,7,8,9,10,11,12
#define PROBE_SUBS  7,7,7,7,7,7,7,7,7,7,7,7,7
#endif

#define LAS __attribute__((address_space(3)))
#define GAS __attribute__((address_space(1)))
typedef unsigned short bf16;
typedef short bf16x8 __attribute__((ext_vector_type(8)));
typedef float f32x4 __attribute__((ext_vector_type(4)));
typedef float f32x2 __attribute__((ext_vector_type(2)));
typedef unsigned u32x4 __attribute__((ext_vector_type(4)));
typedef unsigned u32x2 __attribute__((ext_vector_type(2)));

constexpr int D = 4096, NB = 4, SEQ = 2048, T = NB * SEQ;
constexpr int MEM = 256, TM = NB * MEM;
constexpr int NEXP = 16384;
constexpr float EPS = 1e-6f;
constexpr float LOG2E = 1.4426950408889634f;

typedef __bf16 bf16x2v __attribute__((ext_vector_type(2)));
__device__ __forceinline__ unsigned cvt_pk_bf16(float lo, float hi) { const f32x2 v = {lo, hi}; return __builtin_bit_cast(unsigned, __builtin_convertvector(v, bf16x2v)); }
typedef int i32x4 __attribute__((ext_vector_type(4)));
typedef int i32x8 __attribute__((ext_vector_type(8)));
__device__ __forceinline__ float f8c(float x) { return fminf(fmaxf(x, -448.0f), 448.0f); }
__device__ __forceinline__ unsigned pk4_fp8(float a, float b, float c, float d) { int r = __builtin_amdgcn_cvt_pk_fp8_f32(f8c(a), f8c(b), 0, false); r = __builtin_amdgcn_cvt_pk_fp8_f32(f8c(c), f8c(d), r, true); return (unsigned)r; }
__device__ __forceinline__ float bf_lo(unsigned w) { return __builtin_bit_cast(float, w << 16); }
__device__ __forceinline__ float bf_hi(unsigned w) { return __builtin_bit_cast(float, w & 0xffff0000u); }

constexpr int PQ_WAVE = 2752, PQ_CAP = PQ_WAVE / 32;
namespace pg8 {
constexpr int BM = 256, BK = 64, HALF = 128, HTB = HALF * BK * 2, STAGE_BYTES = 8 * HTB, NXCD = 8, WGM = 8;
__host__ __device__ __forceinline__ int lds_byte(int r, int c) { const int st = (r >> 4) * 2 + (c >> 5), rr = r & 15, cc = c & 31, ob = rr * 64 + cc * 2; return st * 1024 + (ob ^ (((ob >> 9) & 1) << 5)); }
__host__ __device__ __forceinline__ void stage_rc(int b, int& R, int& C) { const int st = b / 1024, sb = b % 1024, swz = sb ^ (((sb >> 9) & 1) << 5); R = (st >> 1) * 16 + swz / 64; C = (st & 1) * 32 + (swz % 64) / 2; }
__host__ __device__ __forceinline__ int perm32(int rho) { const int n = rho >> 4, i = rho & 15; return 8 * (i >> 2) + 4 * n + (i & 3); }

struct Unit { int pm, pn, orow, ocol, kind; };
struct Gemm { const bf16* A; const bf16* Bt; int lda, ldb, K; };

struct TileOrder {
    int nM, nN, nwg, G, c;
    __device__ __forceinline__ void init(int nM_, int nN_, int G_, int c_) { nM = nM_; nN = nN_; nwg = nM * nN; G = G_; c = c_; }
    __device__ __forceinline__ bool tile(int i, int& pm, int& pn) const {
        const long L = (long)i * G + c; if (L >= nwg) return false;
        int wgid = (int)L; { const int q = nwg / NXCD, r = nwg % NXCD, xcd = wgid % NXCD, off = wgid / NXCD; wgid = (xcd < r ? xcd * (q + 1) : r * (q + 1) + (xcd - r) * q) + off; }
        const int nig = WGM * nN, gid = wgid / nig, fm = gid * WGM, gsz = (nM - fm) < WGM ? (nM - fm) : WGM;
        pm = fm + ((wgid % nig) % gsz); pn = (wgid % nig) / gsz; return true;
    }
};
struct SchedPlain : TileOrder {
    __device__ __forceinline__ bool next(int i, Unit& u) const { if (!tile(i, u.pm, u.pn)) return false; u.orow = u.pm * BM; u.ocol = u.pn * BM; return true; }
    __device__ __forceinline__ size_t offA(const Unit& u, const Gemm& g) const { return (size_t)u.pm * BM * g.lda * 2; }
    __device__ __forceinline__ size_t offB(const Unit& u, const Gemm& g) const { return (size_t)u.pn * BM * g.ldb * 2; }
};
struct SchedWp : TileOrder {
    int es;
    __device__ __forceinline__ bool next(int i, Unit& u) const { if (!tile(i, u.pm, u.pn)) return false; u.orow = u.pm * BM; u.ocol = u.pn * BM; return true; }
    __device__ __forceinline__ size_t offA(const Unit& u, const Gemm&) const { return ((size_t)(u.pm >> 2) * 256 * 8192 + (size_t)(u.pm & 3) * 1024) * es; }
    __device__ __forceinline__ size_t offB(const Unit& u, const Gemm&) const { return ((size_t)u.pn * 256 * 4096 + (size_t)(u.pm & 3) * 1024) * es; }
};
struct SchedVp : TileOrder {
    int es;
    __device__ __forceinline__ bool next(int i, Unit& u) const { if (!tile(i, u.pm, u.pn)) return false; u.orow = (u.pn >> 2) * 4096 + u.pm * BM; u.ocol = (u.pn & 3) * BM; return true; }
    __device__ __forceinline__ size_t offA(const Unit& u, const Gemm&) const { return ((size_t)u.pm * 256 * 4096 + (size_t)(u.pn & 3) * 1024) * es; }
    __device__ __forceinline__ size_t offB(const Unit& u, const Gemm&) const { return ((size_t)(u.pn >> 2) * 256 * 8192 + 4096 + (size_t)(u.pn & 3) * 1024) * es; }
};
struct SchedS : TileOrder {
    int es;
    __device__ __forceinline__ bool next(int i, Unit& u) const { if (!tile(i, u.pm, u.pn)) return false; u.orow = u.pm * BM; u.ocol = u.pn * BM; return true; }
    __device__ __forceinline__ size_t offA(const Unit& u, const Gemm&) const { return (size_t)u.pm * 256 * 4096 * es; }
    __device__ __forceinline__ size_t offB(const Unit& u, const Gemm&) const { return ((size_t)(u.pm >> 3) * 1024 + (size_t)u.pn * 256) * 4096 * es; }
};
struct SchedO : TileOrder {
    int es;
    __device__ __forceinline__ bool next(int i, Unit& u) const { if (!tile(i, u.pm, u.pn)) return false; u.orow = u.pm * BM; u.ocol = u.pn * BM; return true; }
    __device__ __forceinline__ size_t offA(const Unit& u, const Gemm&) const { return (size_t)u.pm * 256 * 1024 * es; }
    __device__ __forceinline__ size_t offB(const Unit& u, const Gemm&) const { return ((size_t)(u.pm >> 3) * 4096 + (size_t)u.pn * 256) * 1024 * es; }
};

struct SchedP1 {
    int G, c; size_t x8, win8, memn8, wkv8;
    __device__ __forceinline__ static void tile_lin(int wgid, int nM, int nN, int& pm, int& pn) {
        const int nwg = nM * nN; { const int q = nwg / NXCD, r = nwg % NXCD, xcd = wgid % NXCD, off = wgid / NXCD; wgid = (xcd < r ? xcd * (q + 1) : r * (q + 1) + (xcd - r) * q) + off; }
        const int nig = WGM * nN, gid = wgid / nig, fm = gid * WGM, gsz = (nM - fm) < WGM ? (nM - fm) : WGM;
        pm = fm + ((wgid % nig) % gsz); pn = (wgid % nig) / gsz;
    }
    __device__ __forceinline__ bool next(int i, Unit& u) const {
        const long L = (long)i * G + c; if (L >= 1408) return false;
        int l = (int)L, k, nM, nN;
        if (l < 512) { k = 0; nM = 32; nN = 16; } else if (l < 768) { k = 1; l -= 512; nM = 32; nN = 8; } else if (l < 1024) { k = 2; l -= 768; nM = 8; nN = 32; }
        else if (l < 1280) { k = 3; l -= 1024; nM = 8; nN = 32; } else { k = 4; l -= 1280; nM = 4; nN = 32; }
        tile_lin(l, nM, nN, u.pm, u.pn); u.orow = u.pm * BM; u.ocol = u.pn * BM; u.kind = k; return true;
    }
    __device__ __forceinline__ size_t offA(const Unit& u, const Gemm&) const { const size_t t = (size_t)u.pm * BM * 4096;
        return u.kind < 2 ? x8 + t : u.kind == 2 ? win8 + (size_t)4096 * 4096 + t : u.kind == 3 ? win8 + (size_t)6144 * 4096 + t : memn8 + t; }
    __device__ __forceinline__ size_t offB(const Unit& u, const Gemm&) const { const size_t t = (size_t)u.pn * BM * 4096;
        return u.kind == 0 ? win8 + t : u.kind == 1 ? win8 + (size_t)8192 * 4096 + t : u.kind < 4 ? x8 + t : wkv8 + t; }
};

__device__ __forceinline__ f32x2 gelu_pk(f32x2 v) {
    const f32x2 av = __builtin_elementwise_abs(v), d = av * 0.2316418882f + 1.0f;
    f32x2 t; t.x = __builtin_amdgcn_rcpf(d.x); t.y = __builtin_amdgcn_rcpf(d.y);
    f32x2 q = t * 0.5307027145f + (-0.7265760135f); q = q * t + 0.7107068705f; q = q * t + (-0.142248368f); q = q * t + 0.127414796f; q = q * t;
    const f32x2 s = (v * v) * (-0.72134752044f);
    f32x2 e; e.x = __builtin_amdgcn_exp2f(s.x); e.y = __builtin_amdgcn_exp2f(s.y);
    const f32x2 pos = {fmaxf(v.x, 0.f), fmaxf(v.y, 0.f)};
    return pos - av * (q * e);
}

struct EpiBf16S {
    static constexpr bool PERM = true, HAS_BEGIN = false;
    bf16* O; int ldc; float scale;
    __device__ __forceinline__ void operator()(f32x4 (&acc)[2][2][4][2], const Unit& u, int wr, int wc, int fr, int fq, int par) const {
        const int row0 = u.orow + wr * 64 + fr, col0 = u.ocol + wc * 32 + 8 * fq;
#pragma unroll
        for (int ai = 0; ai < 2; ++ai)
#pragma unroll
            for (int m = 0; m < 4; ++m) { bf16* rowp = O + (size_t)(row0 + ai * HALF + m * 16) * ldc + col0;
#pragma unroll
                for (int bj = 0; bj < 2; ++bj) { const f32x4 v0 = acc[ai][bj][m][0] * scale, v1 = acc[ai][bj][m][1] * scale;
                    u32x4 w; w.x = cvt_pk_bf16(v0[0], v0[1]); w.y = cvt_pk_bf16(v0[2], v0[3]); w.z = cvt_pk_bf16(v1[0], v1[1]); w.w = cvt_pk_bf16(v1[2], v1[3]);
                    *(u32x4*)(rowp + bj * HALF) = w; } }
    }
};
__device__ __forceinline__ float row_rs(const float* rowpart, int row) {
    const f32x4* p = (const f32x4*)(rowpart + (size_t)row * 16); const f32x4 a = p[0], b = p[1], c = p[2], d = p[3];
    const float s = (((a[0] + a[1]) + (a[2] + a[3])) + ((b[0] + b[1]) + (b[2] + b[3]))) + (((c[0] + c[1]) + (c[2] + c[3])) + ((d[0] + d[1]) + (d[2] + d[3])));
    return 1.0f / sqrtf(s * (1.0f / 4096.0f) + 1e-6f);
}
__device__ __forceinline__ void rs_begin(const float* rowpart, LAS unsigned char* rs_tab, int orow, int par) { const int t = threadIdx.x; if (t < 256) ((LAS float*)rs_tab)[par * 256 + t] = row_rs(rowpart, orow + t); }
template <bool BASE_BF16> struct EpiResNorm {
    static constexpr bool PERM = true, HAS_BEGIN = false;
    const void* base; bf16* hb; unsigned char* x8; float* rowpart; LAS unsigned char* xch;
    __device__ __forceinline__ void operator()(f32x4 (&acc)[2][2][4][2], const Unit& u, int wr, int wc, int fr, int fq, int par) const {
        const int row0 = u.orow + wr * 64 + fr, col0 = u.ocol + wc * 32 + 8 * fq;
        LAS float* X = (LAS float*)xch;
#pragma unroll
        for (int ai = 0; ai < 2; ++ai)
#pragma unroll
            for (int m = 0; m < 4; ++m) { const size_t off = (size_t)(row0 + ai * HALF + m * 16) * 4096 + col0;
                f32x4 bs[2][2];
#pragma unroll
                for (int bj = 0; bj < 2; ++bj) {
                    if constexpr (BASE_BF16) { const u32x4 w = *(const u32x4*)((const bf16*)base + off + bj * HALF);
                        bs[bj][0] = (f32x4){bf_lo(w.x), bf_hi(w.x), bf_lo(w.y), bf_hi(w.y)}; bs[bj][1] = (f32x4){bf_lo(w.z), bf_hi(w.z), bf_lo(w.w), bf_hi(w.w)}; }
                    else { bs[bj][0] = *(const f32x4*)((const float*)base + off + bj * HALF); bs[bj][1] = *(const f32x4*)((const float*)base + off + bj * HALF + 4); } }
                float ss = 0.f;
#pragma unroll
                for (int bj = 0; bj < 2; ++bj) { const f32x4 o0 = bs[bj][0] + acc[ai][bj][m][0], o1 = bs[bj][1] + acc[ai][bj][m][1];
                    ss += ((o0[0] * o0[0] + o0[1] * o0[1]) + (o0[2] * o0[2] + o0[3] * o0[3])) + ((o1[0] * o1[0] + o1[1] * o1[1]) + (o1[2] * o1[2] + o1[3] * o1[3]));
                    u32x2 q; q.x = pk4_fp8(16.f * o0[0], 16.f * o0[1], 16.f * o0[2], 16.f * o0[3]); q.y = pk4_fp8(16.f * o1[0], 16.f * o1[1], 16.f * o1[2], 16.f * o1[3]);
                    *(u32x2*)(x8 + off + bj * HALF) = q;
                    u32x4 w; w.x = cvt_pk_bf16(o0[0], o0[1]); w.y = cvt_pk_bf16(o0[2], o0[3]); w.z = cvt_pk_bf16(o1[0], o1[1]); w.w = cvt_pk_bf16(o1[2], o1[3]); *(u32x4*)(hb + off + bj * HALF) = w; }
                ss += __shfl_xor(ss, 16); ss += __shfl_xor(ss, 32);
                if (fq == 0) X[(ai * HALF + wr * 64 + m * 16 + fr) * 4 + wc] = ss;
                asm volatile("" ::: "memory"); }
        asm volatile("s_waitcnt lgkmcnt(0)" ::: "memory"); __builtin_amdgcn_s_barrier(); asm volatile("" ::: "memory");
        if (wc == 0 && fq == 0) {
#pragma unroll
            for (int ai = 0; ai < 2; ++ai)
#pragma unroll
                for (int m = 0; m < 4; ++m) { const int rl = ai * HALF + wr * 64 + m * 16 + fr; const f32x4 p = *(const LAS f32x4*)(X + rl * 4);
                    rowpart[(size_t)(u.orow + rl) * 16 + u.pn] = (p[0] + p[1]) + (p[2] + p[3]); }
        }
    }
};
struct EpiResBf16 {
    static constexpr bool PERM = true, HAS_BEGIN = false;
    bf16* hb;
    __device__ __forceinline__ void operator()(f32x4 (&acc)[2][2][4][2], const Unit& u, int wr, int wc, int fr, int fq, int par) const {
        const int row0 = u.orow + wr * 64 + fr, col0 = u.ocol + wc * 32 + 8 * fq;
        u32x4 bw[8][2];
#pragma unroll
        for (int it = 0; it < 8; ++it) { const bf16* rp = hb + (size_t)(row0 + (it >> 2) * HALF + (it & 3) * 16) * 4096 + col0; bw[it][0] = *(const u32x4*)rp; bw[it][1] = *(const u32x4*)(rp + HALF); }
#pragma unroll
        for (int it = 0; it < 8; ++it) { const int ai = it >> 2, m = it & 3; bf16* rowp = hb + (size_t)(row0 + ai * HALF + m * 16) * 4096 + col0;
#pragma unroll
            for (int bj = 0; bj < 2; ++bj) { const u32x4 b = bw[it][bj]; const f32x4 v0 = acc[ai][bj][m][0], v1 = acc[ai][bj][m][1];
                u32x4 w; w.x = cvt_pk_bf16(bf_lo(b.x) + v0[0], bf_hi(b.x) + v0[1]); w.y = cvt_pk_bf16(bf_lo(b.y) + v0[2], bf_hi(b.y) + v0[3]);
                w.z = cvt_pk_bf16(bf_lo(b.z) + v1[0], bf_hi(b.z) + v1[1]); w.w = cvt_pk_bf16(bf_lo(b.w) + v1[2], bf_hi(b.w) + v1[3]); *(u32x4*)(rowp + bj * HALF) = w; } }
    }
};
struct EpiBf16VT {
    static constexpr bool PERM = true, HAS_BEGIN = false;
    bf16* O; int dvlog2, H;
    __device__ __forceinline__ void operator()(f32x4 (&acc)[2][2][4][2], const Unit& u, int wr, int wc, int fr, int fq, int par) const {
        const int row0 = u.orow + wr * 64 + fr, col0 = u.ocol + wc * 32 + 8 * fq;
#pragma unroll
        for (int ai = 0; ai < 2; ++ai)
#pragma unroll
            for (int m = 0; m < 4; ++m) { const int n = row0 + ai * HALF + m * 16; const int h = n >> dvlog2, d = n & ((1 << dvlog2) - 1);
#pragma unroll
                for (int bj = 0; bj < 2; ++bj) { const int t = col0 + bj * HALF; const int b = t >> 11, mc = (t >> 6) & 31, i = t & 63;
                    const f32x4 v0 = acc[ai][bj][m][0], v1 = acc[ai][bj][m][1];
                    const int p0 = (i & 32) + 16 * ((i >> 3) & 1) + 4 * ((i >> 4) & 1);
                    u32x2 w0, w1; w0.x = cvt_pk_bf16(v0[0], v0[1]); w0.y = cvt_pk_bf16(v0[2], v0[3]); w1.x = cvt_pk_bf16(v1[0], v1[1]); w1.y = cvt_pk_bf16(v1[2], v1[3]);
                    bf16* rp = O + ((((size_t)(b * H + h) * 32 + mc) << dvlog2) + d) * 64 + p0; *(u32x2*)rp = w0; *(u32x2*)(rp + 8) = w1; } }
    }
};
struct EpiBf16QK {
    static constexpr bool PERM = true, HAS_BEGIN = false;
    bf16* O; int ldc; bf16* KT;
    __device__ __forceinline__ void operator()(f32x4 (&acc)[2][2][4][2], const Unit& u, int wr, int wc, int fr, int fq, int par) const {
        const int row0 = u.orow + wr * 64 + fr, col0 = u.ocol + wc * 32 + 8 * fq;
#pragma unroll
        for (int ai = 0; ai < 2; ++ai)
#pragma unroll
            for (int m = 0; m < 4; ++m) { const int row = row0 + ai * HALF + m * 16; const int b = row >> 11, mc = (row >> 6) & 31, i = row & 63;
#pragma unroll
                for (int bj = 0; bj < 2; ++bj) { const f32x4 v0 = acc[ai][bj][m][0], v1 = acc[ai][bj][m][1];
                    u32x4 w; w.x = cvt_pk_bf16(v0[0], v0[1]); w.y = cvt_pk_bf16(v0[2], v0[3]); w.z = cvt_pk_bf16(v1[0], v1[1]); w.w = cvt_pk_bf16(v1[2], v1[3]);
                    if (u.ocol < 2048) *(u32x4*)(O + (size_t)row * ldc + col0 + bj * HALF) = w;
                    else { const int h = ((u.ocol - 2048) >> 7) + bj, d = wc * 32 + 8 * fq; *(u32x4*)(KT + ((((size_t)(b * 16 + h) * 32 + mc) * 64 + i) << 7) + d) = w; } } }
    }
};
struct EpiBf16Rot {
    static constexpr bool PERM = true, HAS_BEGIN = false;
    bf16* O; int ldc; bf16* KT;
    __device__ __forceinline__ void operator()(f32x4 (&acc)[2][2][4][2], const Unit& u, int wr, int wc, int fr, int fq, int par) const {
        const int row0 = u.orow + wr * 64 + fr;
        if (u.ocol < 2048) {
            const int d0 = 32 * (wc & 1) + 8 * fq; float invf[8];
#pragma unroll
            for (int e = 0; e < 8; ++e) invf[e] = __builtin_amdgcn_exp2f((float)(d0 + e) * (-13.287712379549449f / 64.0f)) * 0.15915494309189535f;
            bf16* obase = O + u.ocol + (wc >> 1) * 128 + d0;
#pragma unroll
            for (int ai = 0; ai < 2; ++ai)
#pragma unroll
                for (int m = 0; m < 4; ++m) { const int row = row0 + ai * HALF + m * 16; const float pos = (float)(row & (SEQ - 1));
                    float lo[8], hi[8];
#pragma unroll
                    for (int e = 0; e < 8; ++e) { const float rev = pos * invf[e], frc = rev - floorf(rev); const float sn = __builtin_amdgcn_sinf(frc), cs = __builtin_amdgcn_cosf(frc);
                        const float x1 = acc[ai][0][m][e >> 2][e & 3], x2 = acc[ai][1][m][e >> 2][e & 3]; lo[e] = x1 * cs - x2 * sn; hi[e] = x1 * sn + x2 * cs; }
                    u32x4 wl, wh; wl.x = cvt_pk_bf16(lo[0], lo[1]); wl.y = cvt_pk_bf16(lo[2], lo[3]); wl.z = cvt_pk_bf16(lo[4], lo[5]); wl.w = cvt_pk_bf16(lo[6], lo[7]);
                    wh.x = cvt_pk_bf16(hi[0], hi[1]); wh.y = cvt_pk_bf16(hi[2], hi[3]); wh.z = cvt_pk_bf16(hi[4], hi[5]); wh.w = cvt_pk_bf16(hi[6], hi[7]);
                    if (u.ocol < 1024) { bf16* rowp = obase + (size_t)row * ldc; *(u32x4*)rowp = wl; *(u32x4*)(rowp + 64) = wh; }
                    else { const int b = row >> 11, mc = (row >> 6) & 31, i = row & 63, h = ((u.ocol - 1024) >> 7) + (wc >> 1);
                        bf16* kp = KT + ((((size_t)(b * 8 + h) * 32 + mc) * 64 + i) << 7) + d0; *(u32x4*)kp = wl; *(u32x4*)(kp + 64) = wh; } }
        } else {
            const int col0 = u.ocol + wc * 32 + 8 * fq;
#pragma unroll
            for (int ai = 0; ai < 2; ++ai)
#pragma unroll
                for (int m = 0; m < 4; ++m) { bf16* rowp = O + (size_t)(row0 + ai * HALF + m * 16) * ldc + col0;
#pragma unroll
                    for (int bj = 0; bj < 2; ++bj) { const f32x4 v0 = acc[ai][bj][m][0], v1 = acc[ai][bj][m][1];
                        u32x4 w; w.x = cvt_pk_bf16(v0[0], v0[1]); w.y = cvt_pk_bf16(v0[2], v0[3]); w.z = cvt_pk_bf16(v1[0], v1[1]); w.w = cvt_pk_bf16(v1[2], v1[3]);
                        *(u32x4*)(rowp + bj * HALF) = w; } }
        }
    }
};
struct EpiFp8S {
    static constexpr bool PERM = true, HAS_BEGIN = false;
    unsigned char* O; int ldc; float scale;
    __device__ __forceinline__ void operator()(f32x4 (&acc)[2][2][4][2], const Unit& u, int wr, int wc, int fr, int fq, int par) const {
        const int row0 = u.orow + wr * 64 + fr, col0 = u.ocol + wc * 32 + 8 * fq;
#pragma unroll
        for (int ai = 0; ai < 2; ++ai)
#pragma unroll
            for (int m = 0; m < 4; ++m) { unsigned char* rowp = O + (size_t)(row0 + ai * HALF + m * 16) * ldc + col0;
#pragma unroll
                for (int bj = 0; bj < 2; ++bj) { const f32x4 v0 = acc[ai][bj][m][0] * scale, v1 = acc[ai][bj][m][1] * scale;
                    u32x2 w; w.x = pk4_fp8(v0[0], v0[1], v0[2], v0[3]); w.y = pk4_fp8(v1[0], v1[1], v1[2], v1[3]);
                    *(u32x2*)(rowp + bj * HALF) = w; } }
    }
};
struct EpiP1 {
    static constexpr bool PERM = true, HAS_BEGIN = false;
    EpiBf16QK e0; EpiBf16S e1; EpiBf16VT e2, e3; EpiFp8S e4;
    __device__ __forceinline__ void operator()(f32x4 (&acc)[2][2][4][2], const Unit& u, int wr, int wc, int fr, int fq, int par) const {
        if (u.kind == 0) e0(acc, u, wr, wc, fr, fq, par); else if (u.kind == 1) e1(acc, u, wr, wc, fr, fq, par); else if (u.kind == 2) e2(acc, u, wr, wc, fr, fq, par);
        else if (u.kind == 3) e3(acc, u, wr, wc, fr, fq, par); else e4(acc, u, wr, wc, fr, fq, par);
    }
};
struct EpiF32 {
    static constexpr bool PERM = false, HAS_BEGIN = true;
    float* C; int ldc; const float* rowpart; LAS unsigned char* rs_tab;
    __device__ __forceinline__ void begin(const Unit& u, int par) const { rs_begin(rowpart, rs_tab, u.orow, par); }
    __device__ __forceinline__ void operator()(f32x4 (&acc)[2][2][4][2], const Unit& u, int wr, int wc, int fr, int fq, int par) const {
        const int row0 = u.orow + wr * 64 + fr, col0 = u.ocol + wc * 32 + 4 * fq;
#pragma unroll
        for (int ai = 0; ai < 2; ++ai)
#pragma unroll
            for (int m = 0; m < 4; ++m) { const float rs = ((const LAS float*)rs_tab)[par * 256 + ai * HALF + wr * 64 + m * 16 + fr]; float* rowp = C + (size_t)(row0 + ai * HALF + m * 16) * ldc + col0;
#pragma unroll
                for (int bj = 0; bj < 2; ++bj)
#pragma unroll
                    for (int n = 0; n < 2; ++n) *(f32x4*)(rowp + bj * HALF + n * 16) = acc[ai][bj][m][n] * rs; }
    }
};
struct EpiResF32 {
    static constexpr bool PERM = false, HAS_BEGIN = false;
    const float* base; float* out; int ldc;
    __device__ __forceinline__ void operator()(f32x4 (&acc)[2][2][4][2], const Unit& u, int wr, int wc, int fr, int fq, int par) const {
        const int row0 = u.orow + wr * 64 + fr, col0 = u.ocol + wc * 32 + 4 * fq;
#pragma unroll
        for (int ai = 0; ai < 2; ++ai)
#pragma unroll
            for (int m = 0; m < 4; ++m) { const size_t off = (size_t)(row0 + ai * HALF + m * 16) * ldc + col0;
                f32x4 bs[2][2];
#pragma unroll
                for (int bj = 0; bj < 2; ++bj)
#pragma unroll
                    for (int n = 0; n < 2; ++n) bs[bj][n] = *(const f32x4*)(base + off + bj * HALF + n * 16);
#pragma unroll
                for (int bj = 0; bj < 2; ++bj)
#pragma unroll
                    for (int n = 0; n < 2; ++n) *(f32x4*)(out + off + bj * HALF + n * 16) = bs[bj][n] + acc[ai][bj][m][n];
                asm volatile("" ::: "memory"); }
    }
};
struct EpiSoftmax {
    static constexpr bool PERM = true, HAS_BEGIN = true;
    unsigned char* O; int ldc; LAS unsigned char* xch; float pre; const float* rowpart; LAS unsigned char* rs_tab;
    __device__ __forceinline__ void begin(const Unit& u, int par) const { rs_begin(rowpart, rs_tab, u.orow, par); }
    __device__ __forceinline__ void operator()(f32x4 (&acc)[2][2][4][2], const Unit& u, int wr, int wc, int fr, int fq, int par) const {
        LAS f32x2* X = (LAS f32x2*)xch;
        float mloc[2][4];
#pragma unroll
        for (int ai = 0; ai < 2; ++ai)
#pragma unroll
            for (int m = 0; m < 4; ++m) {
                float mx = -3.0e38f; const float prs = pre * ((const LAS float*)rs_tab)[par * 256 + ai * HALF + wr * 64 + m * 16 + fr];
#pragma unroll
                for (int bj = 0; bj < 2; ++bj)
#pragma unroll
                    for (int n = 0; n < 2; ++n) { const f32x4 x = acc[ai][bj][m][n] * prs; acc[ai][bj][m][n] = x; mx = fmaxf(mx, fmaxf(fmaxf(x[0], x[1]), fmaxf(x[2], x[3]))); }
                mx = fmaxf(mx, __shfl_xor(mx, 16)); mx = fmaxf(mx, __shfl_xor(mx, 32));
                float s = 0.f;
#pragma unroll
                for (int bj = 0; bj < 2; ++bj)
#pragma unroll
                    for (int n = 0; n < 2; ++n) { f32x4 x = acc[ai][bj][m][n];
#pragma unroll
                        for (int j = 0; j < 4; ++j) { x[j] = __builtin_amdgcn_exp2f(x[j] - mx); s += x[j]; }
                        acc[ai][bj][m][n] = x; }
                s += __shfl_xor(s, 16); s += __shfl_xor(s, 32);
                mloc[ai][m] = mx;
                if (fq == 0) X[(ai * HALF + wr * 64 + m * 16 + fr) * 4 + wc] = (f32x2){mx, s};
            }
        asm volatile("s_waitcnt lgkmcnt(0)" ::: "memory"); __builtin_amdgcn_s_barrier(); asm volatile("" ::: "memory");
        const int row0 = u.orow + wr * 64 + fr, col0 = u.ocol + wc * 32 + 8 * fq;
#pragma unroll
        for (int ai = 0; ai < 2; ++ai)
#pragma unroll
            for (int m = 0; m < 4; ++m) {
                const int rl = ai * HALF + wr * 64 + m * 16 + fr;
                const f32x2 p0 = X[rl * 4 + 0], p1 = X[rl * 4 + 1], p2 = X[rl * 4 + 2], p3 = X[rl * 4 + 3];
                const float gm = fmaxf(fmaxf(p0.x, p1.x), fmaxf(p2.x, p3.x));
                const float gl = p0.y * __builtin_amdgcn_exp2f(p0.x - gm) + p1.y * __builtin_amdgcn_exp2f(p1.x - gm) + p2.y * __builtin_amdgcn_exp2f(p2.x - gm) + p3.y * __builtin_amdgcn_exp2f(p3.x - gm);
                const float f = 256.0f * __builtin_amdgcn_exp2f(mloc[ai][m] - gm) / gl;
                unsigned char* rowp = O + (size_t)(row0 + ai * HALF + m * 16) * ldc + col0;
#pragma unroll
                for (int bj = 0; bj < 2; ++bj) { const f32x4 v0 = acc[ai][bj][m][0] * f, v1 = acc[ai][bj][m][1] * f;
                    u32x2 w; w.x = pk4_fp8(v0[0], v0[1], v0[2], v0[3]); w.y = pk4_fp8(v1[0], v1[1], v1[2], v1[3]);
                    *(u32x2*)(rowp + bj * HALF) = w; }
            }
    }
};
struct EpiPeer {
    static constexpr bool PERM = true, HAS_BEGIN = false;
    bf16* GP; int ldc;
    __device__ __forceinline__ void operator()(f32x4 (&acc)[2][2][4][2], const Unit& u, int wr, int wc, int fr, int fq, int par) const {
        const int row0 = u.orow + wr * 64 + fr, col0 = u.ocol + wc * 32 + 8 * fq;
#pragma unroll
        for (int ai = 0; ai < 2; ++ai) {
            u32x4 g[4][2];
#pragma unroll
            for (int m = 0; m < 4; ++m)
#pragma unroll
                for (int bj = 0; bj < 2; ++bj) g[m][bj] = *(const u32x4*)(GP + (size_t)(row0 + ai * HALF + m * 16) * ldc + col0 + bj * HALF);
#pragma unroll
            for (int m = 0; m < 4; ++m) { bf16* rowp = GP + (size_t)(row0 + ai * HALF + m * 16) * ldc + col0;
#pragma unroll
                for (int bj = 0; bj < 2; ++bj) { const f32x4 v0 = acc[ai][bj][m][0], v1 = acc[ai][bj][m][1]; const u32x4 gg = g[m][bj];
                    const f32x2 a = gelu_pk((f32x2){v0[0], v0[1]}), b = gelu_pk((f32x2){v0[2], v0[3]}), c = gelu_pk((f32x2){v1[0], v1[1]}), d = gelu_pk((f32x2){v1[2], v1[3]});
                    u32x4 w; w.x = cvt_pk_bf16(a.x * bf_lo(gg.x), a.y * bf_hi(gg.x)); w.y = cvt_pk_bf16(b.x * bf_lo(gg.y), b.y * bf_hi(gg.y));
                    w.z = cvt_pk_bf16(c.x * bf_lo(gg.z), c.y * bf_hi(gg.z)); w.w = cvt_pk_bf16(d.x * bf_lo(gg.w), d.y * bf_hi(gg.w));
                    *(u32x4*)(rowp + bj * HALF) = w; } }
        }
    }
};

struct EpiPeer8 {
    static constexpr bool PERM = true, HAS_BEGIN = true;
    const unsigned char* G; unsigned char* P8; int ldc; const float* rowpart; LAS unsigned char* rs_tab; LAS unsigned char* pq;
    __device__ __forceinline__ void begin(const Unit& u, int par) const { rs_begin(rowpart, rs_tab, u.orow, par); }
    __device__ __forceinline__ void drain(LAS u32x4* Q, int n, int lane) const {
        for (int r = lane; r < n; r += 64) {
            const u32x4 e0 = Q[2 * r], e1 = Q[2 * r + 1];
            const f32x2 a = gelu_pk((f32x2){bf_lo(e0.x), bf_hi(e0.x)}), b = gelu_pk((f32x2){bf_lo(e0.y), bf_hi(e0.y)}), c = gelu_pk((f32x2){bf_lo(e0.z), bf_hi(e0.z)}), d = gelu_pk((f32x2){bf_lo(e0.w), bf_hi(e0.w)});
            u32x2 w; w.x = pk4_fp8(0.25f * a.x * (float)(e1.x & 255u), 0.25f * a.y * (float)((e1.x >> 8) & 255u), 0.25f * b.x * (float)((e1.x >> 16) & 255u), 0.25f * b.y * (float)(e1.x >> 24));
            w.y = pk4_fp8(0.25f * c.x * (float)(e1.y & 255u), 0.25f * c.y * (float)((e1.y >> 8) & 255u), 0.25f * d.x * (float)((e1.y >> 16) & 255u), 0.25f * d.y * (float)(e1.y >> 24));
            *(u32x2*)(P8 + e1.z) = w;
        }
    }
    __device__ __forceinline__ void operator()(f32x4 (&acc)[2][2][4][2], const Unit& u, int wr, int wc, int fr, int fq, int par) const {
        const int row0 = u.orow + wr * 64 + fr, col0 = u.ocol + wc * 32 + 8 * fq, lane = 16 * fq + fr;
        LAS u32x4* Q = (LAS u32x4*)(pq + (wr * 4 + wc) * PQ_WAVE);
        u32x2 g2[2][4][2];
#pragma unroll
        for (int ai = 0; ai < 2; ++ai)
#pragma unroll
            for (int m = 0; m < 4; ++m)
#pragma unroll
                for (int bj = 0; bj < 2; ++bj) g2[ai][m][bj] = *(const u32x2*)(G + ((((size_t)(u.pm * 64 + u.pn) * 8 + (size_t)(wr * 4 + wc)) * 16 + (size_t)((ai * 4 + m) * 2 + bj)) * 64 + (size_t)lane) * 8);
        int n = 0;
#pragma unroll
        for (int ai = 0; ai < 2; ++ai)
#pragma unroll
            for (int m = 0; m < 4; ++m) { const float rs = ((const LAS float*)rs_tab)[par * 256 + ai * HALF + wr * 64 + m * 16 + fr]; const unsigned roff = (unsigned)(row0 + ai * HALF + m * 16) * (unsigned)ldc + (unsigned)col0;
#pragma unroll
                for (int bj = 0; bj < 2; ++bj) { const u32x2 gg = g2[ai][m][bj]; const bool nz = (gg.x | gg.y) != 0u;
                    const unsigned long long mask = __ballot(nz);
                    if (mask != 0ull) {
                        const int cnt = __builtin_popcountll(mask);
                        if (n + cnt > PQ_CAP) { drain(Q, n, lane); n = 0; }
                        if (nz) { const int pos = n + (int)__builtin_amdgcn_mbcnt_hi((unsigned)(mask >> 32), __builtin_amdgcn_mbcnt_lo((unsigned)mask, 0u));
                            const f32x4 v0 = acc[ai][bj][m][0] * rs, v1 = acc[ai][bj][m][1] * rs;
                            u32x4 e0; e0.x = cvt_pk_bf16(v0[0], v0[1]); e0.y = cvt_pk_bf16(v0[2], v0[3]); e0.z = cvt_pk_bf16(v1[0], v1[1]); e0.w = cvt_pk_bf16(v1[2], v1[3]);
                            Q[2 * pos] = e0; Q[2 * pos + 1] = (u32x4){gg.x, gg.y, roff + (unsigned)(bj * HALF), 0u}; }
                        n += cnt;
                    } } }
        drain(Q, n, lane);
    }
};

template <class Epi, class Sched, bool FP8 = false, int SC8 = 127, bool ALIGN_EPI = true, bool SP2 = true>
__device__ __forceinline__ void gemm_phase(LAS unsigned char* lds, const Gemm g, const Sched& S, const Epi& E) {
    const int tid = threadIdx.x, wid = __builtin_amdgcn_readfirstlane(tid >> 6), lane = tid & 63, wr = wid >> 2, wc = wid & 3, fr = lane & 15, fq = lane >> 4;
    const int K = g.K, nt = K / BK;
    unsigned voffA[2], voffB[2];
#pragma unroll
    for (int i = 0; i < 2; ++i) { int R, C; stage_rc(tid * 16 + i * 8192, R, C); const int Rb = Epi::PERM ? ((R & ~31) + perm32(R & 31)) : R;
        voffA[i] = (unsigned)(R * g.lda + C) * 2u; voffB[i] = (unsigned)(Rb * g.ldb + C) * 2u; }
    const size_t kstep = (size_t)(BK * 2);
    const size_t hstepA = (size_t)HALF * g.lda * 2, hstepB = (size_t)HALF * g.ldb * 2;
    const unsigned ldsw = (unsigned)wid * 1024u;
    const int aoff = lds_byte(wr * 64 + fr, fq * 8), boff = lds_byte(wc * 32 + fr, fq * 8);
#define PG8_SA(b, h) (((b) * 2 + (h)) * HTB)
#define PG8_SB(b, h) ((4 + (b) * 2 + (h)) * HTB)
#define PG8_STAGE(bufoff, gbase, voff) do { _Pragma("unroll") for (int _i = 0; _i < 2; ++_i) \
        __builtin_amdgcn_global_load_lds((const unsigned*)((const char*)(gbase) + (voff)[_i]), (LAS unsigned*)(lds + (bufoff) + ldsw + _i * 8192), 16, 0, 0); } while (0)
#define PG8_LDA(dst, b, h) do { _Pragma("unroll") for (int m = 0; m < 4; ++m) dst[m] = __builtin_shufflevector(*(const LAS i32x4*)(lds + PG8_SA(b, h) + aoff + m * 2048), *(const LAS i32x4*)(lds + PG8_SA(b, h) + aoff + m * 2048 + 1024), 0, 1, 2, 3, 4, 5, 6, 7); } while (0)
#define PG8_LDB(dst, b, h) do { _Pragma("unroll") for (int n = 0; n < 2; ++n) dst[n] = __builtin_shufflevector(*(const LAS i32x4*)(lds + PG8_SB(b, h) + boff + n * 2048), *(const LAS i32x4*)(lds + PG8_SB(b, h) + boff + n * 2048 + 1024), 0, 1, 2, 3, 4, 5, 6, 7); } while (0)
#define PG8_H0(v) __builtin_bit_cast(bf16x8, __builtin_shufflevector(v, v, 0, 1, 2, 3))
#define PG8_H1(v) __builtin_bit_cast(bf16x8, __builtin_shufflevector(v, v, 4, 5, 6, 7))
#define PG8_MMA(ai, bj, At, Bt) do { __builtin_amdgcn_s_setprio(1); \
        if constexpr (FP8) { _Pragma("unroll") for (int m = 0; m < 4; ++m) _Pragma("unroll") for (int n = 0; n < 2; ++n) \
            asm volatile("v_mfma_scale_f32_16x16x128_f8f6f4 %0, %1, %2, %0, %3, %4 op_sel_hi:[0,0,0]" : "+v"(acc[ai][bj][m][n]) : "v"(Bt[n]), "v"(At[m]), "v"(sc8a), "v"(sc8b)); } \
        else { _Pragma("unroll") for (int m = 0; m < 4; ++m) _Pragma("unroll") for (int n = 0; n < 2; ++n) { \
            acc[ai][bj][m][n] = __builtin_amdgcn_mfma_f32_16x16x32_bf16(PG8_H0(Bt[n]), PG8_H0(At[m]), acc[ai][bj][m][n], 0, 0, 0); \
            acc[ai][bj][m][n] = __builtin_amdgcn_mfma_f32_16x16x32_bf16(PG8_H1(Bt[n]), PG8_H1(At[m]), acc[ai][bj][m][n], 0, 0, 0); } } __builtin_amdgcn_s_setprio(0); } while (0)
#define PG8_WAIT_V(n) asm volatile("s_waitcnt vmcnt(" #n ")" ::: "memory")
#define PG8_WAIT_L(n) asm volatile("s_waitcnt lgkmcnt(" #n ")" ::: "memory")
#define PG8_BAR __builtin_amdgcn_s_barrier()
#define PG8_SCHED __builtin_amdgcn_sched_barrier(0)
    Unit cur, nxt; int ui = 0;
    if (!S.next(0, cur)) return;
    f32x4 acc[2][2][4][2];
#pragma unroll
    for (int a = 0; a < 2; ++a)
#pragma unroll
        for (int b = 0; b < 2; ++b)
#pragma unroll
            for (int m = 0; m < 4; ++m)
#pragma unroll
                for (int n = 0; n < 2; ++n) acc[a][b][m][n] = (f32x4){0.f, 0.f, 0.f, 0.f};
    i32x8 At[4], B0[2], B1[2];
    const int sc8a = SC8, sc8b = 127;
    const char* cA = (const char*)g.A + S.offA(cur, g); const char* cB = (const char*)g.Bt + S.offB(cur, g);
    if constexpr (Epi::HAS_BEGIN) E.begin(cur, 0);
    if constexpr (SP2) {
        PG8_STAGE(PG8_SB(0, 0), cB, voffB); PG8_STAGE(PG8_SB(0, 1), cB + hstepB, voffB); PG8_STAGE(PG8_SA(0, 0), cA, voffA); PG8_STAGE(PG8_SA(0, 1), cA + hstepA, voffA);
        if (wr == 1) PG8_BAR;
        PG8_WAIT_V(2); PG8_BAR;
        PG8_STAGE(PG8_SB(1, 0), cB + kstep, voffB); PG8_STAGE(PG8_SA(1, 0), cA + kstep, voffA); PG8_STAGE(PG8_SB(1, 1), cB + hstepB + kstep, voffB);
        PG8_WAIT_V(6); PG8_BAR;
    } else {
        PG8_STAGE(PG8_SB(0, 0), cB, voffB); PG8_STAGE(PG8_SA(0, 0), cA, voffA); PG8_STAGE(PG8_SB(0, 1), cB + hstepB, voffB); PG8_STAGE(PG8_SA(0, 1), cA + hstepA, voffA);
        if (wr == 1) PG8_BAR;
        PG8_WAIT_V(4); PG8_BAR;
        PG8_STAGE(PG8_SB(1, 0), cB + kstep, voffB); PG8_STAGE(PG8_SA(1, 0), cA + kstep, voffA); PG8_STAGE(PG8_SB(1, 1), cB + hstepB + kstep, voffB);
        PG8_WAIT_V(6); PG8_BAR;
    }
    for (;;) {
        const bool has_next = S.next(ui + 1, nxt);
        const char* nA = has_next ? (const char*)g.A + S.offA(nxt, g) : cA; const char* nB = has_next ? (const char*)g.Bt + S.offB(nxt, g) : cB;
        for (int t = 0; t < nt; t += 2) {
            const bool last = (t == nt - 2);
            const char* a1 = cA + (size_t)(t + 1) * kstep;
            const char* a2 = last ? nA : cA + (size_t)(t + 2) * kstep; const char* b2 = last ? nB : cB + (size_t)(t + 2) * kstep;
            const char* a3 = a2 + kstep; const char* b3 = b2 + kstep;
            if constexpr (SP2) {
            PG8_LDB(B0, 0, 0); PG8_LDB(B1, 0, 1); PG8_SCHED; PG8_LDA(At, 0, 0); PG8_STAGE(PG8_SA(1, 1), a1 + hstepA, voffA);
            PG8_WAIT_V(8); PG8_WAIT_L(0); PG8_BAR; PG8_MMA(0, 0, At, B0); PG8_MMA(0, 1, At, B1); PG8_BAR; PG8_SCHED;
            PG8_LDA(At, 0, 1); PG8_STAGE(PG8_SB(0, 0), b2, voffB); PG8_STAGE(PG8_SB(0, 1), b2 + hstepB, voffB); PG8_STAGE(PG8_SA(0, 0), a2, voffA);
            PG8_WAIT_V(8); PG8_WAIT_L(0); PG8_BAR; PG8_MMA(1, 0, At, B0); PG8_MMA(1, 1, At, B1); PG8_BAR; PG8_SCHED;
            PG8_LDB(B0, 1, 0); PG8_LDB(B1, 1, 1); PG8_SCHED; PG8_LDA(At, 1, 0); PG8_STAGE(PG8_SA(0, 1), a2 + hstepA, voffA);
            PG8_WAIT_V(8); PG8_WAIT_L(0); PG8_BAR; PG8_MMA(0, 0, At, B0); PG8_MMA(0, 1, At, B1); PG8_BAR; PG8_SCHED;
            PG8_LDA(At, 1, 1); PG8_STAGE(PG8_SB(1, 0), b3, voffB); PG8_STAGE(PG8_SB(1, 1), b3 + hstepB, voffB); PG8_STAGE(PG8_SA(1, 0), a3, voffA);
            PG8_WAIT_V(8); PG8_WAIT_L(0); PG8_BAR; PG8_MMA(1, 0, At, B0); PG8_MMA(1, 1, At, B1); PG8_BAR; PG8_SCHED;
            } else {
            PG8_LDB(B0, 0, 0); PG8_SCHED; PG8_LDA(At, 0, 0); PG8_STAGE(PG8_SA(1, 1), a1 + hstepA, voffA);
            PG8_WAIT_L(8); PG8_BAR; PG8_WAIT_L(0); PG8_MMA(0, 0, At, B0); PG8_BAR; PG8_SCHED;
            PG8_LDB(B1, 0, 1); PG8_STAGE(PG8_SB(0, 0), b2, voffB);
            PG8_BAR; PG8_WAIT_L(0); PG8_MMA(0, 1, At, B1); PG8_BAR;
            PG8_LDA(At, 0, 1); PG8_STAGE(PG8_SA(0, 0), a2, voffA);
            PG8_BAR; PG8_WAIT_L(0); PG8_MMA(1, 0, At, B0); PG8_BAR; PG8_SCHED;
            PG8_STAGE(PG8_SB(0, 1), b2 + hstepB, voffB);
            PG8_WAIT_V(6); PG8_BAR; PG8_MMA(1, 1, At, B1); PG8_BAR;
            PG8_LDB(B0, 1, 0); PG8_SCHED; PG8_LDA(At, 1, 0); PG8_STAGE(PG8_SA(0, 1), a2 + hstepA, voffA);
            PG8_WAIT_L(8); PG8_BAR; PG8_WAIT_L(0); PG8_MMA(0, 0, At, B0); PG8_BAR; PG8_SCHED;
            PG8_LDB(B1, 1, 1); PG8_STAGE(PG8_SB(1, 0), b3, voffB);
            PG8_BAR; PG8_WAIT_L(0); PG8_MMA(0, 1, At, B1); PG8_BAR;
            PG8_LDA(At, 1, 1); PG8_STAGE(PG8_SA(1, 0), a3, voffA);
            PG8_BAR; PG8_WAIT_L(0); PG8_MMA(1, 0, At, B0); PG8_BAR; PG8_SCHED;
            PG8_STAGE(PG8_SB(1, 1), b3 + hstepB, voffB);
            PG8_WAIT_V(6); PG8_BAR; PG8_MMA(1, 1, At, B1); PG8_BAR;
            }
        }
        if constexpr (ALIGN_EPI) { if (wr == 0) PG8_BAR; }
        if constexpr (FP8) asm volatile("s_nop 15\n\ts_nop 15" ::: "memory");
        { int ln_ = (int)__builtin_amdgcn_mbcnt_hi(~0u, __builtin_amdgcn_mbcnt_lo(~0u, 0u)); asm volatile("" : "+v"(ln_));
          E(acc, cur, wr, wc, ln_ & 15, ln_ >> 4, ui & 1); }
        if (!has_next) break;
#pragma unroll
        for (int a = 0; a < 2; ++a)
#pragma unroll
            for (int b = 0; b < 2; ++b)
#pragma unroll
                for (int m = 0; m < 4; ++m)
#pragma unroll
                    for (int n = 0; n < 2; ++n) acc[a][b][m][n] = (f32x4){0.f, 0.f, 0.f, 0.f};
        cur = nxt; cA = nA; cB = nB; ++ui;
        if constexpr (Epi::HAS_BEGIN) E.begin(cur, ui & 1);
        if constexpr (ALIGN_EPI) { if (wr == 1) PG8_BAR; }
    }
    PG8_WAIT_V(0);
    if constexpr (!ALIGN_EPI) { if (wr == 0) PG8_BAR; }
    PG8_BAR;
#undef PG8_SA
#undef PG8_SB
#undef PG8_STAGE
#undef PG8_LDA
#undef PG8_LDB
#undef PG8_MMA
#undef PG8_H0
#undef PG8_H1
#undef PG8_WAIT_V
#undef PG8_WAIT_L
#undef PG8_BAR
#undef PG8_SCHED
}
}

constexpr size_t MiB = 1u << 20;
constexpr size_t WS_CTL = 0, CTL_ZERO_BYTES = 1 * MiB;
constexpr size_t WS_WIN = 2 * MiB;
constexpr size_t WS_WOUT = 98 * MiB;
constexpr size_t WS_WQ = 130 * MiB;
constexpr size_t WS_WKV = 162 * MiB;
constexpr size_t WS_WO = 226 * MiB;
constexpr size_t WS_WPP = 258 * MiB;
constexpr size_t WS_U = 274 * MiB;
constexpr size_t WS_VT = 402 * MiB;
constexpr size_t WS_XN = 530 * MiB;
constexpr size_t WS_MEMN = 594 * MiB;
constexpr size_t WS_KVM = 602 * MiB;
constexpr size_t WS_WP = 618 * MiB;
constexpr size_t WS_VPT = 650 * MiB;
constexpr size_t WS_PX = 682 * MiB;
constexpr size_t WS_SC = 698 * MiB;
constexpr size_t WS_R1 = 762 * MiB;
constexpr size_t WS_QKVN = WS_R1;
constexpr size_t WS_VTA = WS_R1 + 128 * MiB;
constexpr size_t WS_MIX = WS_R1 + 192 * MiB;
constexpr size_t WS_GP = WS_R1;
constexpr size_t WS_X8 = WS_U + 64 * MiB;
constexpr size_t WS_P8 = 1018 * MiB;
constexpr size_t WS_END = 1146 * MiB;
constexpr int CW_BAR = 4096;

constexpr int RING_OFF = 0, RING_BYTES = 131072;
constexpr int XCH_OFF = RING_BYTES, XCH_BYTES = 8192 + 2048;
constexpr int RS_OFF = XCH_OFF + 8192;
constexpr int LDSCTL_OFF = XCH_OFF + XCH_BYTES, MISC_OFF = LDSCTL_OFF + 320;
constexpr int PQ_OFF = MISC_OFF + 128;
constexpr int LDS_BYTES = 163840;
static_assert(PQ_OFF + 8 * PQ_WAVE <= LDS_BYTES && PQ_OFF % 16 == 0, "LDS map");
constexpr int NWAVES = 8;

#define RLX_AGENT __ATOMIC_RELAXED, __HIP_MEMORY_SCOPE_AGENT
#define LDS_WAIT() asm volatile("s_waitcnt lgkmcnt(0)" ::: "memory")
#define VM_WAIT() asm volatile("s_waitcnt vmcnt(0)" ::: "memory")

#define XB_TMO      128
#define XB_XCNT(j)  (256  + 64 * (j))
#define XB_XSUB(j)  (1280 + 64 * (j))
#define XB_XGEN(j)  (2304 + 64 * (j))
#define XB_TOP      3328
#define XB_TOPGEN   3392
#define XCD_BAR_WORDS 3456
#define XB_SPIN_CAP (1u << 18)
__device__ __forceinline__ unsigned xb_ld(unsigned* p)              { return __hip_atomic_load(p, __ATOMIC_RELAXED, __HIP_MEMORY_SCOPE_AGENT); }
__device__ __forceinline__ unsigned xb_add(unsigned* p, unsigned v) { return __hip_atomic_fetch_add(p, v, __ATOMIC_RELAXED, __HIP_MEMORY_SCOPE_AGENT); }
__device__ __forceinline__ unsigned xb_xcc_id() { return (unsigned)__builtin_amdgcn_s_getreg((3 << 11) | 20) & 0xFu; }
#define XB_SPIN(cond, bar) do { unsigned _sp = 0; while (cond) { __builtin_amdgcn_s_sleep(1); \
    if ((++_sp & 255u) == 0u) { if (xb_ld(&(bar)[XB_TMO])) break; if (_sp > XB_SPIN_CAP) { atomicAdd(&(bar)[XB_TMO], 1u); break; } } } } while (0)
struct XcdBarrier { unsigned* bar; unsigned x; volatile LAS unsigned* st; };
__device__ __forceinline__ XcdBarrier xcd_barrier_post(unsigned* bar, volatile LAS unsigned* st) {
    XcdBarrier b; b.bar = bar; b.x = xb_xcc_id(); b.st = st;
    if (threadIdx.x == 0) (void)xb_add(&bar[XB_XCNT(b.x)], 1u);
    return b;
}
__device__ __forceinline__ void xcd_barrier_complete(unsigned* bar, unsigned x, unsigned& nloc, unsigned& nx) {
    const unsigned G = gridDim.x * gridDim.y * gridDim.z;
    unsigned sum, cnt, mine, sp = 0u;
    for (;;) {
        sum = 0u; cnt = 0u; mine = 0u;
#pragma unroll
        for (unsigned j = 0; j < 16; ++j) { const unsigned c = xb_ld(&bar[XB_XCNT(j)]); sum += c; cnt += (c > 0u) ? 1u : 0u; mine = (j == x) ? c : mine; }
        if (sum == G) break;
        __builtin_amdgcn_s_sleep(1);
        if ((++sp & 255u) == 0u) { if (xb_ld(&bar[XB_TMO])) break; if (sp > XB_SPIN_CAP) { atomicAdd(&bar[XB_TMO], 1u); break; } }
    }
    nloc = mine > 0u ? mine : 1u; nx = cnt > 0u ? cnt : 1u;
}
__device__ __forceinline__ void xcd_barrier(const XcdBarrier& b) {
    asm volatile("s_waitcnt vmcnt(0)" ::: "memory");
    __syncthreads();
    if (threadIdx.x == 0) {
        unsigned* bar = b.bar;
        __builtin_amdgcn_s_waitcnt(0);
        unsigned nloc = b.st[0], nx = b.st[1];
        if (nloc == 0u) { xcd_barrier_complete(bar, b.x, nloc, nx); b.st[0] = nloc; b.st[1] = nx; }
        const unsigned old = xb_add(&bar[XB_XSUB(b.x)], 1u);
        const unsigned gen = old / nloc;
        if (old + 1u == (gen + 1u) * nloc) {
            __builtin_amdgcn_fence(__ATOMIC_RELEASE, "agent");
            asm volatile("s_waitcnt vmcnt(0)" ::: "memory");
            const unsigned og = xb_add(&bar[XB_TOP], 1u);
            const unsigned tg = og / nx;
            if (og + 1u == (tg + 1u) * nx) xb_add(&bar[XB_TOPGEN], 1u);
            else XB_SPIN(xb_ld(&bar[XB_TOPGEN]) == tg, bar);
            __builtin_amdgcn_fence(__ATOMIC_ACQUIRE, "agent");
            xb_add(&bar[XB_XGEN(b.x)], 1u);
            asm volatile("s_waitcnt vmcnt(0)" ::: "memory");
        } else {
            XB_SPIN(xb_ld(&bar[XB_XGEN(b.x)]) == gen, bar);
            __builtin_amdgcn_fence(__ATOMIC_ACQUIRE, "agent");
            asm volatile("s_waitcnt vmcnt(0)" ::: "memory");
        }
    }
    __syncthreads();
}

__device__ __forceinline__ float wave_sum(float v) {
#pragma unroll
    for (int o = 1; o < 64; o <<= 1) v += __shfl_xor(v, o);
    return v;
}
__device__ __forceinline__ unsigned wave_max_u32(unsigned v) {
#pragma unroll
    for (int o = 1; o < 64; o <<= 1) { const unsigned t = (unsigned)__shfl_xor((int)v, o); v = t > v ? t : v; }
    return v;
}
__device__ __forceinline__ void rot_cs(int pos, int i, float& c, float& s) {
    const float inv_freq = __builtin_amdgcn_exp2f((float)i * (-13.287712379549449f / 64.0f));
    const float ang = (float)pos * inv_freq;
    const float rev = ang * 0.15915494309189535f;
    const float fr = rev - floorf(rev);
    s = __builtin_amdgcn_sinf(fr); c = __builtin_amdgcn_cosf(fr);
}

__device__ __forceinline__ void rms_row_bf16(const float* xrow, const float* w, bf16* orow, int lane) {
    const f32x4* xr = (const f32x4*)xrow + lane; const f32x4* wr = (const f32x4*)w + lane;
    f32x4 v[16]; float ss = 0.f;
#pragma unroll
    for (int j = 0; j < 16; ++j) { v[j] = xr[64 * j]; ss += (v[j].x * v[j].x + v[j].y * v[j].y) + (v[j].z * v[j].z + v[j].w * v[j].w); }
    const float rs = 1.0f / sqrtf(wave_sum(ss) * (1.0f / D) + EPS);
    u32x2* o8 = (u32x2*)orow + lane;
#pragma unroll
    for (int j = 0; j < 16; ++j) { const f32x4 g = wr[64 * j]; u32x2 o; o.x = cvt_pk_bf16(v[j].x * rs * g.x, v[j].y * rs * g.y); o.y = cvt_pk_bf16(v[j].z * rs * g.z, v[j].w * rs * g.w); o8[64 * j] = o; }
}
__device__ __forceinline__ void rms_row_bf16_to_f32(const bf16* hrow, const float* w, float* orow, int lane) {
    const u32x4* hr = (const u32x4*)hrow + lane; const f32x4* wr = (const f32x4*)w + lane * 2;
    u32x4 v[8]; float ss = 0.f;
#pragma unroll
    for (int j = 0; j < 8; ++j) { v[j] = hr[64 * j];
#pragma unroll
        for (int e = 0; e < 4; ++e) { const float a = bf_lo(v[j][e]), b = bf_hi(v[j][e]); ss += a * a + b * b; } }
    const float rs = 1.0f / sqrtf(wave_sum(ss) * (1.0f / D) + EPS);
    f32x4* o4 = (f32x4*)orow + lane * 2;
#pragma unroll
    for (int j = 0; j < 8; ++j) { const f32x4 g0 = wr[128 * j], g1 = wr[128 * j + 1];
        o4[128 * j] = (f32x4){bf_lo(v[j].x), bf_hi(v[j].x), bf_lo(v[j].y), bf_hi(v[j].y)} * rs * g0;
        o4[128 * j + 1] = (f32x4){bf_lo(v[j].z), bf_hi(v[j].z), bf_lo(v[j].w), bf_hi(v[j].w)} * rs * g1; }
}
__device__ __forceinline__ void rms_row_f32_inplace(float* xrow, const float* w, int lane) {
    f32x4* xr = (f32x4*)xrow + lane; const f32x4* wr = (const f32x4*)w + lane;
    f32x4 v[16]; float ss = 0.f;
#pragma unroll
    for (int j = 0; j < 16; ++j) { v[j] = xr[64 * j];
#ifdef DBG_SCRUB
        for (int e = 0; e < 4; ++e) if (!(fabsf(v[j][e]) < 1.0e30f)) v[j][e] = 0.f;
#endif
        ss += (v[j].x * v[j].x + v[j].y * v[j].y) + (v[j].z * v[j].z + v[j].w * v[j].w); }
    const float rs = 1.0f / sqrtf(wave_sum(ss) * (1.0f / D) + EPS);
#pragma unroll
    for (int j = 0; j < 16; ++j) { const f32x4 g = wr[64 * j]; xr[64 * j] = v[j] * rs * g; }
}
__device__ __forceinline__ void transpose_item(const float* W, int K, int N, bf16* WT, int k0, int n0, int dst_row0, LAS float* scr, int lane) {
    const int rsub = lane >> 4, c4 = (lane & 15) * 4;
    f32x4 tv[16];
#pragma unroll
    for (int i = 0; i < 16; ++i) tv[i] = *(const f32x4*)(W + (size_t)(k0 + 4 * i + rsub) * N + n0 + c4);
#pragma unroll
    for (int i = 0; i < 16; ++i) { LAS float* d = scr + (4 * i + rsub) * 65 + c4; d[0] = tv[i].x; d[1] = tv[i].y; d[2] = tv[i].z; d[3] = tv[i].w; }
    LDS_WAIT(); asm volatile("" ::: "memory");
    const int c = lane & 7;
#pragma unroll
    for (int j = 0; j < 8; ++j) { const int n = (lane >> 3) + 8 * j; const LAS float* s = scr + (8 * c) * 65 + n;
        u32x4 o; o.x = cvt_pk_bf16(s[0 * 65], s[1 * 65]); o.y = cvt_pk_bf16(s[2 * 65], s[3 * 65]); o.z = cvt_pk_bf16(s[4 * 65], s[5 * 65]); o.w = cvt_pk_bf16(s[6 * 65], s[7 * 65]);
        *(u32x4*)(WT + (size_t)(dst_row0 + n) * K + k0 + 8 * c) = o; }
    LDS_WAIT(); asm volatile("" ::: "memory");
}
__device__ __forceinline__ void convert_item(const float* src, bf16* dst, size_t item, int lane) {
    const f32x4* s = (const f32x4*)(src + item * 2048) + lane * 2; u32x4* d = (u32x4*)(dst + item * 2048) + lane;
#pragma unroll
    for (int j = 0; j < 4; ++j) { const f32x4 a = s[128 * j], b = s[128 * j + 1]; u32x4 o; o.x = cvt_pk_bf16(a.x, a.y); o.y = cvt_pk_bf16(a.z, a.w); o.z = cvt_pk_bf16(b.x, b.y); o.w = cvt_pk_bf16(b.z, b.w); d[64 * j] = o; }
}
__device__ __forceinline__ void convert_item8(const float* src, unsigned char* dst, size_t item, int lane, float scale, const float* colgain) {
    const f32x4* s = (const f32x4*)(src + item * 2048) + lane * 4; u32x4* d = (u32x4*)(dst + item * 2048) + lane;
    const f32x4* cg = colgain ? (const f32x4*)(colgain + (item & 1) * 2048) + lane * 4 : nullptr;
#pragma unroll
    for (int j = 0; j < 2; ++j) { f32x4 a = s[256 * j] * scale, b = s[256 * j + 1] * scale, c = s[256 * j + 2] * scale, e = s[256 * j + 3] * scale;
        if (cg) { a = a * cg[256 * j]; b = b * cg[256 * j + 1]; c = c * cg[256 * j + 2]; e = e * cg[256 * j + 3]; }
        u32x4 o; o.x = pk4_fp8(a.x, a.y, a.z, a.w); o.y = pk4_fp8(b.x, b.y, b.z, b.w); o.z = pk4_fp8(c.x, c.y, c.z, c.w); o.w = pk4_fp8(e.x, e.y, e.z, e.w); d[64 * j] = o; }
}
__device__ __forceinline__ void transpose_item8(const float* W, int K, int N, unsigned char* WT, int k0, int n0, int dst_row0, LAS float* scr, int lane, float scale) {
    const int rsub = lane >> 4, c4 = (lane & 15) * 4;
    f32x4 tv[16];
#pragma unroll
    for (int i = 0; i < 16; ++i) tv[i] = *(const f32x4*)(W + (size_t)(k0 + 4 * i + rsub) * N + n0 + c4);
#pragma unroll
    for (int i = 0; i < 16; ++i) { const f32x4 v = tv[i] * scale; LAS float* d = scr + (4 * i + rsub) * 65 + c4; d[0] = v.x; d[1] = v.y; d[2] = v.z; d[3] = v.w; }
    LDS_WAIT(); asm volatile("" ::: "memory");
    const int c = lane & 3;
#pragma unroll
    for (int j = 0; j < 4; ++j) { const int n = (lane >> 2) + 16 * j; const LAS float* s = scr + (16 * c) * 65 + n;
        u32x4 o; o.x = pk4_fp8(s[0 * 65], s[1 * 65], s[2 * 65], s[3 * 65]); o.y = pk4_fp8(s[4 * 65], s[5 * 65], s[6 * 65], s[7 * 65]);
        o.z = pk4_fp8(s[8 * 65], s[9 * 65], s[10 * 65], s[11 * 65]); o.w = pk4_fp8(s[12 * 65], s[13 * 65], s[14 * 65], s[15 * 65]);
        *(u32x4*)(WT + (size_t)(dst_row0 + n) * K + k0 + 16 * c) = o; }
    LDS_WAIT(); asm volatile("" ::: "memory");
}
__device__ __forceinline__ void transpose_item8b(const float* W, int K, int N, unsigned char* WT, int k0, int n0, int dst_row0, LAS float* scr, int lane, float scale) {
    const int rsub = lane >> 3, c4 = (lane & 7) * 4;
    f32x4 tv[16];
#pragma unroll
    for (int i = 0; i < 16; ++i) tv[i] = *(const f32x4*)(W + (size_t)(k0 + 8 * i + rsub) * N + n0 + c4);
#pragma unroll
    for (int i = 0; i < 16; ++i) { const f32x4 v = tv[i] * scale; LAS float* d = scr + (8 * i + rsub) * 33 + c4; d[0] = v.x; d[1] = v.y; d[2] = v.z; d[3] = v.w; }
    LDS_WAIT(); asm volatile("" ::: "memory");
#pragma unroll
    for (int jn = 0; jn < 2; ++jn)
#pragma unroll
        for (int jc = 0; jc < 2; ++jc) { const int n = (lane & 15) + 16 * jn, c = (lane >> 4) + 4 * jc; const LAS float* sp = scr + (16 * c) * 33 + n;
            u32x4 o; o.x = pk4_fp8(sp[0 * 33], sp[1 * 33], sp[2 * 33], sp[3 * 33]); o.y = pk4_fp8(sp[4 * 33], sp[5 * 33], sp[6 * 33], sp[7 * 33]);
            o.z = pk4_fp8(sp[8 * 33], sp[9 * 33], sp[10 * 33], sp[11 * 33]); o.w = pk4_fp8(sp[12 * 33], sp[13 * 33], sp[14 * 33], sp[15 * 33]);
            *(u32x4*)(WT + (size_t)(dst_row0 + n) * K + k0 + 16 * c) = o; }
    LDS_WAIT(); asm volatile("" ::: "memory");
}
__device__ __forceinline__ void rms_row_fp8(const float* xrow, const float* w, unsigned char* o8row, int lane) {
    const f32x4* xr = (const f32x4*)xrow + lane; const f32x4* wr = (const f32x4*)w + lane;
    f32x4 v[16]; float ss = 0.f;
#pragma unroll
    for (int j = 0; j < 16; ++j) { v[j] = xr[64 * j]; ss += (v[j].x * v[j].x + v[j].y * v[j].y) + (v[j].z * v[j].z + v[j].w * v[j].w); }
    const float rs = 16.0f / sqrtf(wave_sum(ss) * (1.0f / D) + EPS);
    unsigned* q8 = (unsigned*)o8row + lane;
#pragma unroll
    for (int j = 0; j < 16; ++j) { const f32x4 g = wr[64 * j]; const f32x4 y = v[j] * rs * g; q8[64 * j] = pk4_fp8(y.x, y.y, y.z, y.w); }
}
__device__ __forceinline__ void rms_row_bf16_fp8(const float* xrow, const float* w, bf16* orow, unsigned char* o8row, int lane) {
    const f32x4* xr = (const f32x4*)xrow + lane; const f32x4* wr = (const f32x4*)w + lane;
    f32x4 v[16]; float ss = 0.f;
#pragma unroll
    for (int j = 0; j < 16; ++j) { v[j] = xr[64 * j]; ss += (v[j].x * v[j].x + v[j].y * v[j].y) + (v[j].z * v[j].z + v[j].w * v[j].w); }
    const float rs = 1.0f / sqrtf(wave_sum(ss) * (1.0f / D) + EPS);
    u32x2* o8 = (u32x2*)orow + lane; unsigned* q8 = (unsigned*)o8row + lane;
#pragma unroll
    for (int j = 0; j < 16; ++j) { const f32x4 g = wr[64 * j]; const f32x4 y = v[j] * rs * g; u32x2 o; o.x = cvt_pk_bf16(y.x, y.y); o.y = cvt_pk_bf16(y.z, y.w); o8[64 * j] = o;
        q8[64 * j] = pk4_fp8(16.f * y.x, 16.f * y.y, 16.f * y.z, 16.f * y.w); }
}
__device__ __forceinline__ void rms_rows_bf16_fp8(const float* x, const LAS float* gl, bf16* xn, unsigned char* x8, int gw, int ngw, int nrows, int lane) {
    if (gw >= nrows) return;
    f32x4 cur[16], nxt[16];
    { const f32x4* xr = (const f32x4*)(x + (size_t)gw * D) + lane;
#pragma unroll
      for (int j = 0; j < 16; ++j) cur[j] = xr[64 * j]; }
    const LAS f32x4* g4 = (const LAS f32x4*)gl + lane;
    for (int m = gw; m < nrows; m += ngw) {
        const bool more = m + ngw < nrows;
        if (more) { const f32x4* xr = (const f32x4*)(x + (size_t)(m + ngw) * D) + lane;
#pragma unroll
            for (int j = 0; j < 16; ++j) nxt[j] = xr[64 * j]; }
        __builtin_amdgcn_sched_barrier(0);
        float ss = 0.f;
#pragma unroll
        for (int j = 0; j < 16; ++j) ss += (cur[j].x * cur[j].x + cur[j].y * cur[j].y) + (cur[j].z * cur[j].z + cur[j].w * cur[j].w);
        const float rs = 1.0f / sqrtf(wave_sum(ss) * (1.0f / D) + EPS);
        u32x2* o8 = (u32x2*)(xn + (size_t)m * D) + lane; unsigned* q8 = (unsigned*)(x8 + (size_t)m * D) + lane;
#pragma unroll
        for (int j = 0; j < 16; ++j) { const f32x4 y = cur[j] * rs * g4[64 * j]; u32x2 o; o.x = cvt_pk_bf16(y.x, y.y); o.y = cvt_pk_bf16(y.z, y.w); o8[64 * j] = o;
            q8[64 * j] = pk4_fp8(16.f * y.x, 16.f * y.y, 16.f * y.z, 16.f * y.w); }
        __builtin_amdgcn_sched_barrier(0);
        if (more) {
#pragma unroll
            for (int j = 0; j < 16; ++j) cur[j] = nxt[j]; }
    }
}
__device__ __forceinline__ void rms_rows_bf16_to_f32(const bf16* h, const LAS float* gl, float* out, int gw, int ngw, int nrows, int lane) {
    if (gw >= nrows) return;
    u32x4 cur[8], nxt[8];
    { const u32x4* hr = (const u32x4*)(h + (size_t)gw * D) + lane;
#pragma unroll
      for (int j = 0; j < 8; ++j) cur[j] = hr[64 * j]; }
    const LAS f32x4* g4 = (const LAS f32x4*)gl + lane * 2;
    for (int m = gw; m < nrows; m += ngw) {
        const bool more = m + ngw < nrows;
        if (more) { const u32x4* hr = (const u32x4*)(h + (size_t)(m + ngw) * D) + lane;
#pragma unroll
            for (int j = 0; j < 8; ++j) nxt[j] = hr[64 * j]; }
        __builtin_amdgcn_sched_barrier(0);
        float ss = 0.f;
#pragma unroll
        for (int j = 0; j < 8; ++j)
#pragma unroll
            for (int e = 0; e < 4; ++e) { const float a = bf_lo(cur[j][e]), b = bf_hi(cur[j][e]); ss += a * a + b * b; }
        const float rs = 1.0f / sqrtf(wave_sum(ss) * (1.0f / D) + EPS);
        f32x4* o4 = (f32x4*)(out + (size_t)m * D) + lane * 2;
#pragma unroll
        for (int j = 0; j < 8; ++j) { const f32x4 g0 = g4[128 * j], g1 = g4[128 * j + 1];
            o4[128 * j] = (f32x4){bf_lo(cur[j].x), bf_hi(cur[j].x), bf_lo(cur[j].y), bf_hi(cur[j].y)} * rs * g0;
            o4[128 * j + 1] = (f32x4){bf_lo(cur[j].z), bf_hi(cur[j].z), bf_lo(cur[j].w), bf_hi(cur[j].w)} * rs * g1; }
        __builtin_amdgcn_sched_barrier(0);
        if (more) {
#pragma unroll
            for (int j = 0; j < 8; ++j) cur[j] = nxt[j]; }
    }
}
__device__ __forceinline__ bf16x8 ld8_f32_bf16(const float* p) { const f32x4 a = *(const f32x4*)p, b = *(const f32x4*)(p + 4); u32x4 o; o.x = cvt_pk_bf16(a.x, a.y); o.y = cvt_pk_bf16(a.z, a.w); o.z = cvt_pk_bf16(b.x, b.y); o.w = cvt_pk_bf16(b.z, b.w); return __builtin_bit_cast(bf16x8, o); }
__device__ __forceinline__ bf16x8 cvt8_bf16(const f32x4 a, const f32x4 b) { u32x4 o; o.x = cvt_pk_bf16(a.x, a.y); o.y = cvt_pk_bf16(a.z, a.w); o.z = cvt_pk_bf16(b.x, b.y); o.w = cvt_pk_bf16(b.z, b.w); return __builtin_bit_cast(bf16x8, o); }
__device__ __forceinline__ void wpp_item(const float* wq, const float* sk, const float* cgain, bf16* WppT, int item, int lane) {
    const int hp = item >> 8, c0 = (item & 255) * 16, fr = lane & 15, fq = lane >> 4;
    f32x4 araw[4][2];
#pragma unroll
    for (int ds = 0; ds < 4; ++ds) { const float* pa = wq + (size_t)(c0 + fr) * 2048 + hp * 128 + 32 * ds + 8 * fq; araw[ds][0] = *(const f32x4*)pa; araw[ds][1] = *(const f32x4*)(pa + 4); }
    const f32x4 cg = *(const f32x4*)(cgain + c0 + 4 * fq);
    bf16x8 af[4];
#pragma unroll
    for (int h2 = 0; h2 < 2; ++h2) {
        f32x4 braw[4][4][2];
#pragma unroll
        for (int k4 = 0; k4 < 4; ++k4)
#pragma unroll
            for (int ds = 0; ds < 4; ++ds) { const float* pb = sk + ((size_t)hp * 128 + 16 * (4 * h2 + k4) + fr) * 128 + 32 * ds + 8 * fq; braw[k4][ds][0] = *(const f32x4*)pb; braw[k4][ds][1] = *(const f32x4*)(pb + 4); }
        __builtin_amdgcn_sched_barrier(0);
        if (h2 == 0) {
#pragma unroll
            for (int ds = 0; ds < 4; ++ds) af[ds] = cvt8_bf16(araw[ds][0], araw[ds][1]); }
#pragma unroll
        for (int k4 = 0; k4 < 4; ++k4) { const int kt = 4 * h2 + k4;
            f32x4 acc = (f32x4){0.f, 0.f, 0.f, 0.f};
#pragma unroll
            for (int ds = 0; ds < 4; ++ds) acc = __builtin_amdgcn_mfma_f32_16x16x32_bf16(af[ds], cvt8_bf16(braw[k4][ds][0], braw[k4][ds][1]), acc, 0, 0, 0);
            acc = acc * cg;
            u32x2 o; o.x = cvt_pk_bf16(acc[0], acc[1]); o.y = cvt_pk_bf16(acc[2], acc[3]);
            *(u32x2*)(WppT + (size_t)(hp * 128 + 16 * kt + fr) * 4096 + c0 + 4 * fq) = o; }
        __builtin_amdgcn_sched_barrier(0);
    }
}

constexpr int ATT_K0 = 0, ATT_KB = 16384, ATT_V0 = 32768, ATT_VB = 40960, ATT_VROW = 160;
static_assert(ATT_V0 + 2 * ATT_VB <= RING_BYTES, "attention LDS");

__device__ __forceinline__ void attn_unit(LAS unsigned char* lds, const bf16* __restrict__ qkvn, const bf16* __restrict__ kT, const bf16* __restrict__ vT, unsigned char* __restrict__ mix, const float* __restrict__ rel_bias,
                                          int b, int h, int qb, int tid, int wid, int lane) {
    asm volatile("" : "+v"(tid), "+v"(lane), "+s"(wid));
    const int fr = lane & 15, fq = lane >> 4;
    LAS float* biasl = (LAS float*)(lds + XCH_OFF);
    __syncthreads();
    for (int i = tid; i < 832; i += 512) biasl[i] = rel_bias[h * 513 + (i < 512 ? i : 512)] * LOG2E;
    const int t0 = b * SEQ + qb * 256;
    const int nw = qb * 4 + (wid >> 1);
    const int m_lo = (qb * 4 - 8) > 0 ? (qb * 4 - 8) : 0, m_hi = qb * 4 + 3;
    bf16x8 qf[2][4];
#pragma unroll
    for (int qt = 0; qt < 2; ++qt)
#pragma unroll
        for (int ks = 0; ks < 4; ++ks) qf[qt][ks] = *(const bf16x8*)(qkvn + (size_t)(t0 + 32 * wid + 16 * qt + fr) * 8192 + h * 128 + 32 * ks + 8 * fq);
    f32x4 oacc[8][2];
#pragma unroll
    for (int dt = 0; dt < 8; ++dt) { oacc[dt][0] = (f32x4){0.f, 0.f, 0.f, 0.f}; oacc[dt][1] = (f32x4){0.f, 0.f, 0.f, 0.f}; }
    float mrow[2] = {-1.0e30f, -1.0e30f}, lrow[2] = {0.f, 0.f};
    u32x4 kr[2], vr[2];
    const bf16* kbase = kT + (size_t)(b * 16 + h) * 32 * 8192;
    const bf16* vbase = vT + (size_t)(b * 16 + h) * 32 * 8192;
#define ATT_LOAD(m) do { _Pragma("unroll") for (int i = 0; i < 2; ++i) { const int id = tid + 512 * i; \
        kr[i] = *(const u32x4*)(kbase + (size_t)(m) * 8192 + id * 8); \
        vr[i] = *(const u32x4*)(vbase + (size_t)(m) * 8192 + id * 8); } } while (0)
#define ATT_WRITE(buf) do { _Pragma("unroll") for (int i = 0; i < 2; ++i) { const int id = tid + 512 * i; const int kr_ = id >> 4, kc_ = id & 15; \
        *(LAS u32x4*)(lds + ATT_K0 + (buf) * ATT_KB + kr_ * 256 + ((kc_ ^ (kr_ & 15)) << 4)) = kr[i]; \
        *(LAS u32x4*)(lds + ATT_V0 + (buf) * ATT_VB + (id >> 3) * ATT_VROW + (id & 7) * 16) = vr[i]; } } while (0)
    ATT_LOAD(m_lo); ATT_WRITE(0);
    __syncthreads();
    const float SCALE = 0.08838834764831845f * LOG2E;
    for (int m = m_lo; m <= m_hi; ++m) {
        const int cur = (m - m_lo) & 1;
        if (m < m_hi) ATT_LOAD(m + 1);
        if (m >= nw - 8 && m <= nw) {
            const LAS unsigned char* Kb = lds + ATT_K0 + cur * ATT_KB; const LAS unsigned char* Vb = lds + ATT_V0 + cur * ATT_VB;
            f32x4 sacc[4][2];
#pragma unroll
            for (int kt = 0; kt < 4; ++kt) { sacc[kt][0] = (f32x4){0.f, 0.f, 0.f, 0.f}; sacc[kt][1] = (f32x4){0.f, 0.f, 0.f, 0.f}; }
            __builtin_amdgcn_s_setprio(1);
#pragma unroll
            for (int ks = 0; ks < 4; ++ks)
#pragma unroll
                for (int kt = 0; kt < 4; ++kt) { const bf16x8 kf = *(const LAS bf16x8*)(Kb + (16 * kt + fr) * 256 + (((4 * ks + fq) ^ fr) << 4));
                    sacc[kt][0] = __builtin_amdgcn_mfma_f32_16x16x32_bf16(kf, qf[0][ks], sacc[kt][0], 0, 0, 0);
                    sacc[kt][1] = __builtin_amdgcn_mfma_f32_16x16x32_bf16(kf, qf[1][ks], sacc[kt][1], 0, 0, 0);
                    if (kt == 3) __builtin_amdgcn_sched_barrier(0); }
            __builtin_amdgcn_s_setprio(0);
            const int dc = nw - m;
            bf16x8 pf[2][2];
#pragma unroll
            for (int qt = 0; qt < 2; ++qt) {
                const int qi = 32 * (wid & 1) + 16 * qt + fr;
                float mx = -3.0e38f;
                const LAS float* bp = biasl + (64 * dc + qi + 256 - 4 * fq - 63);
#pragma unroll
                for (int kt = 0; kt < 4; ++kt)
#pragma unroll
                    for (int r = 0; r < 4; ++r) { const float v = sacc[kt][qt][r] * SCALE + bp[63 - 16 * kt - r]; sacc[kt][qt][r] = v; mx = fmaxf(mx, v); }
                mx = fmaxf(mx, __shfl_xor(mx, 16)); mx = fmaxf(mx, __shfl_xor(mx, 32));
                if (__any(mx > mrow[qt] + 8.0f)) {
                    const float mnew = fmaxf(mrow[qt], mx), alpha = __builtin_amdgcn_exp2f(mrow[qt] - mnew);
                    mrow[qt] = mnew; lrow[qt] = lrow[qt] * alpha;
#pragma unroll
                    for (int dt = 0; dt < 8; ++dt) oacc[dt][qt] = oacc[dt][qt] * alpha;
                }
                const float mcur = mrow[qt];
                float ls = 0.f;
#pragma unroll
                for (int kt = 0; kt < 4; ++kt)
#pragma unroll
                    for (int r = 0; r < 4; ++r) { const float p = __builtin_amdgcn_exp2f(sacc[kt][qt][r] - mcur); sacc[kt][qt][r] = p; ls += p; }
                lrow[qt] += ls;
#pragma unroll
                for (int s = 0; s < 2; ++s) { u32x4 w; w.x = cvt_pk_bf16(sacc[2 * s][qt][0], sacc[2 * s][qt][1]); w.y = cvt_pk_bf16(sacc[2 * s][qt][2], sacc[2 * s][qt][3]);
                    w.z = cvt_pk_bf16(sacc[2 * s + 1][qt][0], sacc[2 * s + 1][qt][1]); w.w = cvt_pk_bf16(sacc[2 * s + 1][qt][2], sacc[2 * s + 1][qt][3]); pf[qt][s] = __builtin_bit_cast(bf16x8, w); }
                __builtin_amdgcn_sched_barrier(0);
            }
            __builtin_amdgcn_s_setprio(1);
#pragma unroll
            for (int dt = 0; dt < 8; ++dt)
#pragma unroll
                for (int s = 0; s < 2; ++s) { const bf16x8 vf = *(const LAS bf16x8*)(Vb + (16 * dt + fr) * ATT_VROW + 64 * s + 16 * fq);
                    oacc[dt][0] = __builtin_amdgcn_mfma_f32_16x16x32_bf16(vf, pf[0][s], oacc[dt][0], 0, 0, 0);
                    oacc[dt][1] = __builtin_amdgcn_mfma_f32_16x16x32_bf16(vf, pf[1][s], oacc[dt][1], 0, 0, 0);
                    if ((dt & 3) == 3 && s == 1) __builtin_amdgcn_sched_barrier(0); }
            __builtin_amdgcn_s_setprio(0);
        }
        if (m < m_hi) ATT_WRITE(cur ^ 1);
        __syncthreads();
    }
#undef ATT_LOAD
#undef ATT_WRITE
#pragma unroll
    for (int qt = 0; qt < 2; ++qt) {
        float l = lrow[qt]; l += __shfl_xor(l, 16); l += __shfl_xor(l, 32);
        const float inv = 1.0f / l;
        unsigned char* orow = mix + (size_t)(t0 + 32 * wid + 16 * qt + fr) * 4096 + h * 128 + 4 * fq;
        const float inv128 = 128.0f * inv;
#pragma unroll
        for (int dt = 0; dt < 8; ++dt) { const f32x4 o = oacc[dt][qt] * inv128; *(unsigned*)(orow + 16 * dt) = pk4_fp8(o[0], o[1], o[2], o[3]); }
    }
}

__device__ __forceinline__ void ret_unit(LAS unsigned char* lds, const bf16* __restrict__ qkvn, const bf16* __restrict__ kT, const bf16* __restrict__ vT, unsigned char* __restrict__ mix, const float* __restrict__ gn_w,
                                         int b, int h, int qb2, int tid, int wid, int lane) {
    asm volatile("" : "+v"(tid), "+v"(lane), "+s"(wid));
    const int fr = lane & 15, fq = lane >> 4;
    __syncthreads();
    const int t0 = b * SEQ + qb2 * 128;
    const int nw = qb2 * 2 + (wid >> 2);
    const int m_hi = qb2 * 2 + 1;
    float lg2g; { const float x = __builtin_amdgcn_exp2f((float)(-5 - h)); lg2g = -(x * (1.0f + x * (0.5f + x * (0.33333334f + x * (0.25f + x * (0.2f + x * 0.16666667f)))))) * LOG2E; }
    bf16x8 qf[4];
#pragma unroll
    for (int ks = 0; ks < 4; ++ks) qf[ks] = *(const bf16x8*)(qkvn + (size_t)(t0 + 16 * wid + fr) * 8192 + 4096 + h * 128 + 32 * ks + 8 * fq);
    f32x4 oacc[16];
#pragma unroll
    for (int dt = 0; dt < 16; ++dt) oacc[dt] = (f32x4){0.f, 0.f, 0.f, 0.f};
    u32x4 kr[2], vr[4];
    const bf16* kbase = kT + (size_t)(b * 8 + h) * 32 * 8192;
    const bf16* vbase = vT + (size_t)(b * 8 + h) * 32 * 16384;
#define RET_LOAD(m) do { _Pragma("unroll") for (int i = 0; i < 2; ++i) { const int id = tid + 512 * i; kr[i] = *(const u32x4*)(kbase + (size_t)(m) * 8192 + id * 8); } \
        _Pragma("unroll") for (int i = 0; i < 4; ++i) { const int id = tid + 512 * i; vr[i] = *(const u32x4*)(vbase + (size_t)(m) * 16384 + id * 8); } } while (0)
#define RET_W1(buf, i) do { if ((i) < 2) *(LAS u32x4*)(lds + ATT_K0 + (buf) * ATT_KB + kw0 + (i) * 8192) = kr[(i) & 1];        \
        else *(LAS u32x4*)(lds + ATT_V0 + (buf) * ATT_VB + vw0 + ((i) - 2) * 64 * ATT_VROW) = vr[((i) - 2) & 3]; } while (0)
#define RET_WRITE(buf) do { RET_W1(buf, 0); RET_W1(buf, 1); RET_W1(buf, 2); RET_W1(buf, 3); RET_W1(buf, 4); RET_W1(buf, 5); } while (0)
#define RET_BAR() do { asm volatile("s_waitcnt lgkmcnt(0)" ::: "memory"); __builtin_amdgcn_s_barrier(); asm volatile("" ::: "memory"); } while (0)
    const int kw0 = (tid >> 4) * 256 + (((tid & 15) ^ ((tid >> 4) & 15)) << 4), vw0 = (tid >> 3) * ATT_VROW + (tid & 7) * 16;
    RET_LOAD(0); RET_WRITE(0); RET_LOAD(1);
    RET_BAR();
    const int qi = 16 * (wid & 3) + fr;
    const float rowf = 0.08838834764831845f * __builtin_amdgcn_exp2f(lg2g * (float)qi);
    float colr[4], colk[4];
#pragma unroll
    for (int r = 0; r < 4; ++r) { colr[r] = __builtin_amdgcn_exp2f(-lg2g * (float)(4 * fq + r));
        colk[r] = __builtin_bit_cast(float, __builtin_amdgcn_readfirstlane(__builtin_bit_cast(int, __builtin_amdgcn_exp2f(-lg2g * (float)(16 * r))))); }
#define RET_SB() __builtin_amdgcn_sched_barrier(0)
#define RET_LDK(F, ks) do { _Pragma("unroll") for (int kt = 0; kt < 4; ++kt) F[kt] = *(const LAS bf16x8*)(Kb + (16 * kt + fr) * 256 + (((4 * (ks) + fq) ^ fr) << 4)); } while (0)
#define RET_LDV(F, g) do { _Pragma("unroll") for (int e = 0; e < 4; ++e) F[e] = *(const LAS bf16x8*)(Vb + (16 * (2 * (g) + (e >> 1)) + fr) * ATT_VROW + 64 * (e & 1) + 16 * fq); } while (0)
#define RET_MMK(F, ks) do { _Pragma("unroll") for (int kt = 0; kt < 4; ++kt) sacc[kt] = __builtin_amdgcn_mfma_f32_16x16x32_bf16(F[kt], qf[ks], sacc[kt], 0, 0, 0); } while (0)
#define RET_MMV(F, g) do { _Pragma("unroll") for (int e = 0; e < 4; ++e) oacc[2 * (g) + (e >> 1)] = __builtin_amdgcn_mfma_f32_16x16x32_bf16(F[e], pf[e & 1], oacc[2 * (g) + (e >> 1)], 0, 0, 0); } while (0)
#define RET_COMPUTE(mm, buf, ml) do { const int m_ = (mm); if (m_ <= nw) { \
            const LAS unsigned char* Kb = lds + ATT_K0 + (m_ & 1) * ATT_KB; const LAS unsigned char* Vb = lds + ATT_V0 + (m_ & 1) * ATT_VB; \
            f32x4 sacc[4]; bf16x8 fa[4], fb[4]; \
            _Pragma("unroll") for (int kt = 0; kt < 4; ++kt) sacc[kt] = (f32x4){0.f, 0.f, 0.f, 0.f}; \
            RET_LDK(fa, 0); RET_SB(); \
            RET_LDK(fb, 1); RET_SB(); RET_MMK(fa, 0); RET_SB(); \
            RET_LDK(fa, 2); RET_SB(); RET_MMK(fb, 1); RET_SB(); \
            RET_LDK(fb, 3); RET_SB(); RET_MMK(fa, 2); RET_SB(); \
            RET_LDV(fa, 0); RET_SB(); RET_MMK(fb, 3); RET_SB(); \
            RET_LDV(fb, 1); RET_SB(); \
            if (m_ < nw) { const float rs_ = rowf * __builtin_amdgcn_exp2f(lg2g * (float)(64 * (nw - m_))); \
                _Pragma("unroll") for (int kt = 0; kt < 4; ++kt) { const float rk_ = rs_ * colk[kt]; _Pragma("unroll") for (int r = 0; r < 4; ++r) sacc[kt][r] = sacc[kt][r] * (rk_ * colr[r]); } \
            } else { \
                _Pragma("unroll") for (int kt = 0; kt < 4; ++kt) _Pragma("unroll") for (int r = 0; r < 4; ++r) { int dist = qi - (16 * kt + 4 * fq + r); dist = dist < 0 ? -dist : dist; \
                        sacc[kt][r] = sacc[kt][r] * (0.08838834764831845f * __builtin_amdgcn_exp2f(lg2g * (float)dist)); } } \
            bf16x8 pf[2]; \
            _Pragma("unroll") for (int s = 0; s < 2; ++s) { u32x4 w; w.x = cvt_pk_bf16(sacc[2 * s][0], sacc[2 * s][1]); w.y = cvt_pk_bf16(sacc[2 * s][2], sacc[2 * s][3]); \
                w.z = cvt_pk_bf16(sacc[2 * s + 1][0], sacc[2 * s + 1][1]); w.w = cvt_pk_bf16(sacc[2 * s + 1][2], sacc[2 * s + 1][3]); pf[s] = __builtin_bit_cast(bf16x8, w); } \
            RET_SB(); \
            RET_MMV(fa, 0); RET_SB(); RET_LDV(fa, 2); RET_SB(); \
            RET_MMV(fb, 1); RET_SB(); RET_LDV(fb, 3); RET_W1(buf, 0); RET_SB(); \
            RET_MMV(fa, 2); RET_SB(); RET_LDV(fa, 4); RET_W1(buf, 1); RET_SB(); \
            RET_MMV(fb, 3); RET_SB(); RET_LDV(fb, 5); RET_W1(buf, 2); RET_SB(); \
            RET_MMV(fa, 4); RET_SB(); RET_LDV(fa, 6); RET_W1(buf, 3); RET_SB(); \
            RET_MMV(fb, 5); RET_SB(); RET_LDV(fb, 7); RET_W1(buf, 4); RET_SB(); \
            RET_MMV(fa, 6); RET_SB(); RET_W1(buf, 5); RET_SB(); RET_MMV(fb, 7); RET_SB(); \
        } else { RET_WRITE(buf); } RET_LOAD(ml); } while (0)
    for (int m = 0; m <= m_hi; m += 2) {
        { const int ml = m + 2 <= m_hi ? m + 2 : m_hi; RET_COMPUTE(m, 1, ml); }
        RET_BAR();
        { const int ml = m + 3 <= m_hi ? m + 3 : m_hi; RET_COMPUTE(m + 1, 0, ml); }
        RET_BAR();
    }
#undef RET_LOAD
#undef RET_WRITE
#undef RET_COMPUTE
#undef RET_W1
#undef RET_SB
#undef RET_LDK
#undef RET_LDV
#undef RET_MMK
#undef RET_MMV
#undef RET_BAR
    float s1 = 0.f;
#pragma unroll
    for (int dt = 0; dt < 16; ++dt) s1 += (oacc[dt][0] + oacc[dt][1]) + (oacc[dt][2] + oacc[dt][3]);
    s1 += __shfl_xor(s1, 16); s1 += __shfl_xor(s1, 32);
    const float mu = s1 * (1.0f / 256.0f);
    float s2 = 0.f;
#pragma unroll
    for (int dt = 0; dt < 16; ++dt) { const f32x4 d = oacc[dt] - mu; s2 += (d[0] * d[0] + d[1] * d[1]) + (d[2] * d[2] + d[3] * d[3]); }
    s2 += __shfl_xor(s2, 16); s2 += __shfl_xor(s2, 32);
    const float rstd = 1.0f / sqrtf(s2 * (1.0f / 256.0f) + EPS);
    const size_t trow = (size_t)(t0 + 16 * wid + fr);
    const bf16* grow = qkvn + trow * 8192 + 6144 + h * 256 + 4 * fq;
    unsigned char* orow = mix + trow * 4096 + 2048 + h * 256 + 4 * fq;
    const float* gw = gn_w + h * 256 + 4 * fq;
#pragma unroll
    for (int dt = 0; dt < 16; ++dt) {
        const u32x2 gg = *(const u32x2*)(grow + 16 * dt); const f32x4 w = *(const f32x4*)(gw + 16 * dt);
        const float g0 = bf_lo(gg.x), g1 = bf_hi(gg.x), g2 = bf_lo(gg.y), g3 = bf_hi(gg.y);
        const f32x4 yn = (oacc[dt] - mu) * rstd * w;
        const float o0 = yn[0] * g0 / (1.0f + __builtin_amdgcn_exp2f(-g0 * LOG2E)), o1 = yn[1] * g1 / (1.0f + __builtin_amdgcn_exp2f(-g1 * LOG2E));
        const float o2 = yn[2] * g2 / (1.0f + __builtin_amdgcn_exp2f(-g2 * LOG2E)), o3 = yn[3] * g3 / (1.0f + __builtin_amdgcn_exp2f(-g3 * LOG2E));
        *(unsigned*)(orow + 16 * dt) = pk4_fp8(16.f * o0, 16.f * o1, 16.f * o2, 16.f * o3);
        if ((dt & 3) == 3) asm volatile("" ::: "memory");
    }
}

__device__ __forceinline__ unsigned key_pack(float v, int k) { unsigned u = __builtin_bit_cast(unsigned, v); u = (u & 0x80000000u) ? ~u : (u | 0x80000000u); return (u & ~127u) | (unsigned)(127 - k); }
__device__ __forceinline__ float key_val(unsigned p) { unsigned u = p & ~127u; u = (u & 0x80000000u) ? (u & 0x7fffffffu) : ~u; return __builtin_bit_cast(float, u); }
__device__ __forceinline__ float rdl_f(float v, int l) { return __builtin_bit_cast(float, __builtin_amdgcn_readlane(__builtin_bit_cast(int, v), l)); }

template <int CTRL> __device__ __forceinline__ unsigned dpp_u(unsigned v) { return (unsigned)__builtin_amdgcn_update_dpp((int)v, (int)v, CTRL, 0xf, 0xf, false); }
__device__ __forceinline__ unsigned row_max_u(unsigned v) { unsigned t;
    t = dpp_u<0xB1>(v); v = t > v ? t : v; t = dpp_u<0x4E>(v); v = t > v ? t : v; t = dpp_u<0x141>(v); v = t > v ? t : v; t = dpp_u<0x140>(v); v = t > v ? t : v; return v; }
__device__ __forceinline__ float row_sum_f(float v) {
    v += __builtin_bit_cast(float, dpp_u<0xB1>(__builtin_bit_cast(unsigned, v))); v += __builtin_bit_cast(float, dpp_u<0x4E>(__builtin_bit_cast(unsigned, v)));
    v += __builtin_bit_cast(float, dpp_u<0x141>(__builtin_bit_cast(unsigned, v))); v += __builtin_bit_cast(float, dpp_u<0x140>(__builtin_bit_cast(unsigned, v))); return v; }
#define TK_CE(a, b) do { const unsigned hi_ = (a) > (b) ? (a) : (b), lo_ = (a) > (b) ? (b) : (a); (a) = hi_; (b) = lo_; } while (0)
__device__ __forceinline__ unsigned ord_u(float v) { const unsigned u = __builtin_bit_cast(unsigned, v); return (u & 0x80000000u) ? ~u : (u | 0x80000000u); }
__device__ __forceinline__ float ord_f(unsigned u) { return __builtin_bit_cast(float, (u & 0x80000000u) ? (u & 0x7fffffffu) : ~u); }

__device__ __forceinline__ void topk_phase(LAS unsigned char* lds, const float* __restrict__ scores, unsigned char* __restrict__ G, int gw, int ngw, int wid, int lane) {
    LAS unsigned* bm = (LAS unsigned*)(lds + wid * 2048);
    LAS unsigned char* lut = (LAS unsigned char*)(lds + 16384 + wid * 64);
#pragma unroll
    for (int i = 0; i < 8; ++i) bm[lane + 64 * i] = 0u;
    { int ci = 0, cj = 0, cnt = 0;
#pragma unroll
      for (int i = 0; i < 16; ++i) { const int n = 16 / (i + 1); if (lane >= cnt && lane < cnt + n) { ci = i; cj = lane - cnt; } cnt += n; }
      lut[lane] = (unsigned char)((ci << 4) | cj); }
    LDS_WAIT();
    const int l = lane & 15, rowbase = lane & 48; const bool oddrow = (lane & 16) != 0;
    int ic[4], jc[4];
#pragma unroll
    for (int sidx = 0; sidx < 4; ++sidx) { const int c = 4 * l + sidx; const unsigned ij = lut[c < 50 ? c : 0]; ic[sidx] = rowbase + (int)(ij >> 4); jc[sidx] = rowbase + (int)(ij & 15u); }
    for (int t = gw; t < T; t += ngw) {
        unsigned char* Grow = G + (size_t)t * NEXP;
        unsigned res[4];
        {
            unsigned k[4][8];
            const f32x4* sr = (const f32x4*)(scores + (size_t)t * 2048) + lane * 2;
#pragma unroll
            for (int p = 0; p < 4; ++p) { const f32x4 a = sr[p * 128], b = sr[p * 128 + 1];
#pragma unroll
                for (int e = 0; e < 4; ++e) { k[p][e] = (ord_u(a[e]) & ~127u) | (unsigned)(127 - (8 * l + e)); k[p][4 + e] = (ord_u(b[e]) & ~127u) | (unsigned)(127 - (8 * l + 4 + e)); }
                TK_CE(k[p][0], k[p][1]); TK_CE(k[p][2], k[p][3]); TK_CE(k[p][4], k[p][5]); TK_CE(k[p][6], k[p][7]);
                TK_CE(k[p][0], k[p][2]); TK_CE(k[p][1], k[p][3]); TK_CE(k[p][4], k[p][6]); TK_CE(k[p][5], k[p][7]);
                TK_CE(k[p][1], k[p][2]); TK_CE(k[p][5], k[p][6]);
                TK_CE(k[p][0], k[p][4]); TK_CE(k[p][1], k[p][5]); TK_CE(k[p][2], k[p][6]); TK_CE(k[p][3], k[p][7]);
                TK_CE(k[p][2], k[p][4]); TK_CE(k[p][3], k[p][5]);
                TK_CE(k[p][1], k[p][2]); TK_CE(k[p][3], k[p][4]); TK_CE(k[p][5], k[p][6]);
                res[p] = 0u; }
            for (int r = 0; r < 16; ++r) {
#pragma unroll
                for (int p = 0; p < 4; ++p) { const unsigned mm = row_max_u(k[p][0]); res[p] = (l == r) ? mm : res[p]; const bool pop = k[p][0] == mm;
#pragma unroll
                    for (int e = 0; e < 7; ++e) k[p][e] = pop ? k[p][e + 1] : k[p][e];
                    k[p][7] = pop ? 0u : k[p][7]; }
            }
        }
        int ee[2]; float gg[2]; bool dup[2];
#pragma unroll
        for (int q = 0; q < 2; ++q) {
            const unsigned tx = (unsigned)__shfl((int)res[2 * q + 1], lane - 16), ty = (unsigned)__shfl((int)res[2 * q], lane + 16);
            const unsigned X = oddrow ? tx : res[2 * q], Y = oddrow ? res[2 * q + 1] : ty;
            const float xv = ord_f(X & ~127u), yv = ord_f(Y & ~127u);
            unsigned ck[4];
#pragma unroll
            for (int sidx = 0; sidx < 4; ++sidx) { const float sum = __shfl(xv, ic[sidx]) + __shfl(yv, jc[sidx]); const int c = 4 * l + sidx;
                ck[sidx] = (c < 50) ? ((ord_u(sum) & ~63u) | (unsigned)(63 - c)) : 0u; }
            TK_CE(ck[0], ck[1]); TK_CE(ck[2], ck[3]); TK_CE(ck[0], ck[2]); TK_CE(ck[1], ck[3]); TK_CE(ck[1], ck[2]);
            unsigned win = 0u;
            for (int r = 0; r < 16; ++r) { const unsigned mm = row_max_u(ck[0]); win = (l == r) ? mm : win; const bool pop = ck[0] == mm;
                ck[0] = pop ? ck[1] : ck[0]; ck[1] = pop ? ck[2] : ck[1]; ck[2] = pop ? ck[3] : ck[2]; ck[3] = pop ? 0u : ck[3]; }
            const unsigned ij = lut[63 - (int)(win & 63u)];
            const int ia = 127 - (int)((unsigned)__shfl((int)X, rowbase + (int)(ij >> 4)) & 127u), ib = 127 - (int)((unsigned)__shfl((int)Y, rowbase + (int)(ij & 15u)) & 127u);
            const float val = ord_f(win & ~63u), vmax = __shfl(val, rowbase);
            const float ex = __builtin_amdgcn_exp2f((val - vmax) * LOG2E);
            gg[q] = ex / row_sum_f(ex); ee[q] = ia * 128 + ib; dup[q] = false;
        }
#pragma unroll
        for (int q = 0; q < 2; ++q) { const unsigned bit = 1u << (ee[q] & 31); const unsigned old = __hip_atomic_fetch_or(&bm[ee[q] >> 5], bit, __ATOMIC_RELAXED, __HIP_MEMORY_SCOPE_WORKGROUP); dup[q] = (old & bit) != 0u; }
#pragma unroll
        for (int q = 0; q < 2; ++q) { unsigned long long db = __ballot(dup[q]);
            while (db) { const int L = __builtin_ctzll(db); const int es = __builtin_amdgcn_readlane(ee[q], L); const float gs = rdl_f(gg[q], L);
#pragma unroll
                for (int q2 = 0; q2 < 2; ++q2) if (!dup[q2] && ee[q2] == es) gg[q2] += gs;
                db &= db - 1ull; } }
#pragma unroll
        for (int q = 0; q < 2; ++q) bm[ee[q] >> 5] = 0u;
#pragma unroll
        for (int q = 0; q < 2; ++q) if (!dup[q]) { const float qv = fminf(gg[q] * 128.0f + 0.5f, 255.0f);
            const int e_ = ee[q], row_ = t & 255, col_ = e_ & 255;
            const size_t off_ = ((((size_t)((t >> 8) * 64 + (e_ >> 8)) * 8 + (size_t)(((row_ >> 6) & 1) * 4 + ((col_ >> 5) & 3))) * 16 + (size_t)(((row_ >> 7) * 4 + ((row_ >> 4) & 3)) * 2 + (col_ >> 7))) * 64 + (size_t)(((col_ >> 3) & 3) * 16 + (row_ & 15))) * 8 + (size_t)(col_ & 7);
            G[off_] = (unsigned char)(unsigned)qv; }
    }
}
#undef TK_CE

struct Args { const float* in[18]; float* out; unsigned char* ws; int ph_lo, ph_hi, sub, pad; };
constexpr int NPHASE = 13;

__global__ void __launch_bounds__(NWAVES * 64, 2) fwd(Args args) {
    extern __shared__ __attribute__((aligned(16))) unsigned char lds_raw[];
    LAS unsigned char* lds = (LAS unsigned char*)lds_raw;
    volatile LAS unsigned* MISC = (volatile LAS unsigned*)(lds + MISC_OFF);
    const int tid = threadIdx.x, lane = tid & 63, wave = __builtin_amdgcn_readfirstlane(tid >> 6);
    const int G = gridDim.x, bx = blockIdx.x;
    const int vcu = (G % 8 == 0) ? (bx % 8) * (G / 8) + bx / 8 : bx;
    const int gw = vcu * NWAVES + wave, NGW = G * NWAVES;
    unsigned char* ws = args.ws;
    const float* x = args.in[0]; const float* mem = args.in[1]; const float* norm1_w = args.in[2]; const float* w_in = args.in[3]; const float* rel_bias = args.in[4];
    const float* gn_w = args.in[5]; const float* w_out = args.in[6]; const float* norm2_w = args.in[7]; const float* memn_w = args.in[8]; const float* xwq = args.in[9];
    const float* xwkv = args.in[10]; const float* xwo = args.in[11]; const float* norm3_w = args.in[12]; const float* pwq = args.in[13]; const float* psk = args.in[14];
    const float* pu = args.in[15]; const float* pv = args.in[16]; const float* fin_w = args.in[17];
    float* hout = args.out;
    bf16* W_IN = (bf16*)(ws + WS_WIN); bf16* W_OUT = (bf16*)(ws + WS_WOUT); bf16* W_Q = (bf16*)(ws + WS_WQ); bf16* W_KV = (bf16*)(ws + WS_WKV); bf16* W_O = (bf16*)(ws + WS_WO);
    bf16* W_PP = (bf16*)(ws + WS_WPP); bf16* W_U = (bf16*)(ws + WS_U); bf16* W_VT = (bf16*)(ws + WS_VT);
    bf16* XN = (bf16*)(ws + WS_XN); bf16* MEMN = (bf16*)(ws + WS_MEMN); bf16* KVM = (bf16*)(ws + WS_KVM); bf16* WP = (bf16*)(ws + WS_WP); bf16* VPT = (bf16*)(ws + WS_VPT);
    float* RP1 = (float*)(ws + 1 * MiB); float* RP2 = (float*)(ws + 1 * MiB + 512 * 1024);
    bf16* VT_A = (bf16*)(ws + WS_VTA); bf16* VT_R = (bf16*)(ws + WS_VTA + 32 * MiB); bf16* KT_A = (bf16*)(ws + WS_SC); bf16* KT_R = (bf16*)(ws + WS_SC + 32 * MiB);
    unsigned char* W_Q8 = ws + WS_WQ; unsigned char* W_KV8 = ws + WS_WKV; unsigned char* W_O8 = ws + WS_WO; unsigned char* MEMN8 = ws + WS_MEMN;
    unsigned char* KVM8 = ws + WS_KVM; unsigned char* WP8 = ws + WS_WP; unsigned char* VPT8 = ws + WS_VPT; unsigned char* PX8 = ws + WS_PX;
    unsigned char* W_IN8 = ws + WS_WIN;
    bf16* W_INB = (bf16*)(ws + WS_WIN + 40 * MiB);
    unsigned char* U8 = ws + WS_U; unsigned char* VT8 = ws + WS_VT; unsigned char* X8 = ws + WS_X8; unsigned char* P8 = ws + WS_P8;
    bf16* PX = (bf16*)(ws + WS_PX); float* SC = (float*)(ws + WS_SC); bf16* QKVN = (bf16*)(ws + WS_QKVN); bf16* VTA = (bf16*)(ws + WS_VTA); unsigned char* MIX8 = ws + WS_MIX; unsigned char* W_OUT8 = ws + WS_WOUT; bf16* GP = (bf16*)(ws + WS_GP); unsigned char* G8 = ws + WS_GP;

    for (int u = tid; u < (LDS_BYTES - LDSCTL_OFF) / 4; u += NWAVES * 64) ((LAS unsigned*)(lds + LDSCTL_OFF))[u] = 0u;
    __syncthreads();
    const int lo = args.ph_lo, hi = args.ph_hi;
    XcdBarrier bar; bar.bar = (unsigned*)(ws + WS_CTL) + CW_BAR; bar.x = 0; bar.st = nullptr;
    if (hi - lo > 1) bar = xcd_barrier_post((unsigned*)(ws + WS_CTL) + CW_BAR, MISC + 8);
#ifndef PHASE_MASK
#define PHASE_MASK 0xffff
#endif
#define IN(k) (((PHASE_MASK >> (k)) & 1) && lo <= (k) && (k) < hi)
#define SEAM(k) do { if (IN(k) && IN((k) + 1)) xcd_barrier(bar); } while (0)
#define SEAM2(k) do { if (IN(k) && IN((k) + 2)) xcd_barrier(bar); } while (0)

    if (IN(0)) {
        { int t_ = tid; asm volatile("" : "+v"(t_)); LAS f32x4* gl4 = (LAS f32x4*)(lds + PQ_OFF); const f32x4* gw4 = (const f32x4*)norm1_w; gl4[t_] = gw4[t_]; gl4[t_ + 512] = gw4[t_ + 512]; }
        __syncthreads();
        LAS float* scr = (LAS float*)(lds + wave * 16896);
        LAS float* scr8 = (LAS float*)(lds + wave * 16896);
        {
            constexpr int J1 = 32 * 192, J1B = 32 * 128, J2 = 32 * 128, J3 = 32 * 256, J4 = 32 * 128, J5 = 128 * 128, NJ = J1 + J1B + J2 + J3 + J4 + J5;
            for (int it = gw; it < NJ; it += NGW) {
                int r = it;
                if (r < J1) { const int n0 = (r % 192) * 32; transpose_item8b(w_in, 4096, 12288, W_IN8, (r / 192) * 128, n0, n0, scr8, lane, 1024.0f); continue; } r -= J1;
                if (r < J1B) { const int n0 = 8192 + (r % 128) * 32; transpose_item8b(w_in, 4096, 12288, W_IN8, (r / 128) * 128, n0, n0 - 2048, scr8, lane, 1024.0f); continue; } r -= J1B;

                if (r < J2) { const int k0 = (r / 128) * 128, n0 = (r % 128) * 32; transpose_item8b(w_out, 4096, 4096, W_OUT8, k0, n0, n0, scr8, lane, k0 < 2048 ? 128.0f : 1024.0f); continue; } r -= J2;
                if (r < J3) { const int n0 = (r % 256) * 32; transpose_item8b(xwkv, 4096, 8192, W_KV8, (r / 256) * 128, n0, n0, scr8, lane, 1024.0f); continue; } r -= J3;
                if (r < J4) { const int n0 = (r % 128) * 32; transpose_item8b(xwo, 4096, 4096, W_O8, (r / 128) * 128, n0, n0, scr8, lane, 1024.0f); continue; } r -= J4;
                { const int n0 = (r % 128) * 32; transpose_item8b(pv, 16384, 4096, VT8, (r / 128) * 128, n0, n0, scr8, lane, 32.0f); }
            }
        }
        {
            for (int it = gw; it < 64 * 32; it += NGW) { const int kb = it / 32, n0 = 6144 + (it % 32) * 64;
                int dr = n0 - 6144;
                { const int t_old = (dr >> 6) & 3; dr = (dr & ~255) + 64 * (2 * (t_old & 1) + (t_old >> 1)); }
                transpose_item(w_in, 4096, 12288, W_INB, kb * 64, n0, dr, scr, lane); }
        }
        for (int it = gw; it < 8192; it += NGW) convert_item8(xwq, W_Q8, (size_t)it, lane, 1024.0f * norm2_w[it >> 1], nullptr);
        for (int it = gw; it < 32768; it += NGW) convert_item8(pu, U8, (size_t)it, lane, 1024.0f, norm3_w);
        rms_rows_bf16_fp8(x, (const LAS float*)(lds + PQ_OFF), XN, X8, gw, NGW, T, lane);
        for (int m = gw; m < TM; m += NGW) rms_row_fp8(mem + (size_t)m * D, memn_w, MEMN8 + (size_t)m * D, lane);
        for (int it = gw; it < 4096; it += NGW) wpp_item(pwq, psk, norm3_w, W_PP, it, lane);
    }
    SEAM(0);
    if (IN(1)) {
        { pg8::Gemm g{XN, W_INB, 4096, 4096, 4096}; pg8::SchedPlain S; S.init(32, 8, G, bx); pg8::EpiBf16Rot E{QKVN + 4096, 8192, KT_R};
          pg8::gemm_phase<pg8::EpiBf16Rot, pg8::SchedPlain>(lds + RING_OFF, g, S, E); }
        { pg8::Gemm g{(const bf16*)ws, (const bf16*)ws, 2048, 2048, 2048};
          pg8::SchedP1 S{G, bx, WS_X8, WS_WIN, WS_MEMN, WS_WKV};
          pg8::EpiP1 E{pg8::EpiBf16QK{QKVN, 8192, KT_A}, pg8::EpiBf16S{QKVN + 4096 + 2048, 8192, 1.0f}, pg8::EpiBf16VT{VT_A, 7, 16}, pg8::EpiBf16VT{VT_R, 8, 8}, pg8::EpiFp8S{KVM8, 8192, 16.0f}};
          pg8::gemm_phase<pg8::EpiP1, pg8::SchedP1, true, 113>(lds + RING_OFF, g, S, E); }
        if (bx >= 128 || G < 256) {
            const int nz = (G < 256) ? G : G - 128, zi = (G < 256) ? bx : bx - 128;
            u32x4* gz = (u32x4*)P8; const size_t n16 = (size_t)T * NEXP / 16;
            for (size_t i = (size_t)zi * 512 + tid; i < n16; i += (size_t)nz * 512) gz[i] = (u32x4){0u, 0u, 0u, 0u};
        }
    }
    SEAM(1);
    if (IN(2)) {
        if (args.sub & 1) {
        { pg8::Gemm g{(const bf16*)KVM8, (const bf16*)W_Q8, 4096, 2048, 512}; pg8::SchedWp S; S.init(16, 16, G, bx); S.es = 1; pg8::EpiFp8S E{WP8, 4096, 32.0f};
          pg8::gemm_phase<pg8::EpiFp8S, pg8::SchedWp, true, 113>(lds + RING_OFF, g, S, E); }
        { pg8::Gemm g{(const bf16*)W_O8, (const bf16*)KVM8, 2048, 4096, 512}; pg8::SchedVp S; S.init(16, 16, G, bx); S.es = 1; pg8::EpiFp8S E{VPT8, 1024, 32.0f};
          pg8::gemm_phase<pg8::EpiFp8S, pg8::SchedVp, true, 113>(lds + RING_OFF, g, S, E); }
        }
        if (args.sub & 2)
        for (int p = vcu; p < 256; p += G) { const int bh = p >> 2, k = p & 3;
            attn_unit(lds, QKVN, KT_A, VT_A, MIX8, rel_bias, bh >> 4, bh & 15, 7 - k, tid, wave, lane);
            attn_unit(lds, QKVN, KT_A, VT_A, MIX8, rel_bias, bh >> 4, bh & 15, k, tid, wave, lane); }
        if (args.sub & 4)
        for (int p = vcu; p < 256; p += G) { const int bh = p >> 3, j = p & 7;
            ret_unit(lds, QKVN, KT_R, VT_R, MIX8, gn_w, bh >> 3, bh & 7, 15 - j, tid, wave, lane);
            ret_unit(lds, QKVN, KT_R, VT_R, MIX8, gn_w, bh >> 3, bh & 7, j, tid, wave, lane); }
        __syncthreads();
    }
    SEAM(2);
    if (IN(3)) {
        pg8::Gemm g{(const bf16*)MIX8, (const bf16*)W_OUT8, 2048, 2048, 2048}; pg8::SchedPlain S; S.init(32, 16, G, bx); pg8::EpiResNorm<false> E{x, XN, X8, RP1, lds + XCH_OFF};
        pg8::gemm_phase<pg8::EpiResNorm<false>, pg8::SchedPlain, true, 113>(lds + RING_OFF, g, S, E);
    }
    SEAM2(3);
    if (IN(5)) {
        pg8::Gemm g{(const bf16*)X8, (const bf16*)WP8, 2048, 2048, 2048}; pg8::SchedS S; S.init(32, 4, G, bx); S.es = 1; pg8::EpiSoftmax E{PX8, 1024, lds + XCH_OFF, 0.03125f * LOG2E, RP1, lds + RS_OFF};
        pg8::gemm_phase<pg8::EpiSoftmax, pg8::SchedS, true, 118>(lds + RING_OFF, g, S, E);
        if (bx >= 128 || G < 256) {
            const int nz = (G < 256) ? G : G - 128, zi = (G < 256) ? bx : bx - 128;
            u32x4* gz = (u32x4*)G8; const size_t n16 = (size_t)T * NEXP / 16;
            for (size_t i = (size_t)zi * 512 + tid; i < n16; i += (size_t)nz * 512) gz[i] = (u32x4){0u, 0u, 0u, 0u};
        }
    }
    SEAM(5);
    if (IN(6)) {
        pg8::Gemm g{(const bf16*)PX8, (const bf16*)VPT8, 512, 512, 512}; pg8::SchedO S; S.init(32, 16, G, bx); S.es = 1; pg8::EpiResNorm<true> E{XN, XN, X8, RP2, lds + XCH_OFF};
        pg8::gemm_phase<pg8::EpiResNorm<true>, pg8::SchedO, true, 114>(lds + RING_OFF, g, S, E);
    }
    SEAM2(6);
    if (IN(8)) {
        pg8::Gemm g{XN, W_PP, 4096, 4096, 4096}; pg8::SchedPlain S; S.init(32, 8, G, bx); pg8::EpiF32 E{SC, 2048, RP2, lds + RS_OFF};
        pg8::gemm_phase<pg8::EpiF32, pg8::SchedPlain>(lds + RING_OFF, g, S, E);
    }
    SEAM(8);
    if (IN(9)) { topk_phase(lds, SC, G8, gw, NGW, wave, lane); }
    SEAM(9);
    if (IN(10)) {
        pg8::Gemm g{(const bf16*)X8, (const bf16*)U8, 2048, 2048, 2048}; pg8::SchedPlain S; S.init(32, 64, G, bx); pg8::EpiPeer8 E{G8, P8, NEXP, RP2, lds + RS_OFF, lds + PQ_OFF};
        pg8::gemm_phase<pg8::EpiPeer8, pg8::SchedPlain, true, 113>(lds + RING_OFF, g, S, E);
    }
    SEAM(10);
    if (IN(11)) {
        pg8::Gemm g{(const bf16*)P8, (const bf16*)VT8, NEXP / 2, NEXP / 2, NEXP / 2}; pg8::SchedPlain S; S.init(32, 16, G, bx); pg8::EpiResBf16 E{XN};
        pg8::gemm_phase<pg8::EpiResBf16, pg8::SchedPlain, true, 117>(lds + RING_OFF, g, S, E);
    }
    SEAM(11);
#ifdef DBG_CHECK
    if (IN(13)) {
        for (int t = gw; t < T; t += NGW) {
            float sum = 0.f; int bad = 0;
#if DBG_CHECK == 1
            const u32x4* gr = (const u32x4*)(GP + (size_t)t * NEXP);
            for (int i = 0; i < 32; ++i) { const u32x4 w = gr[i * 64 + lane];
                for (int e = 0; e < 4; ++e) { const float a = bf_lo(w[e]), b = bf_hi(w[e]); if (!(fabsf(a) < 1e30f) || !(fabsf(b) < 1e30f)) bad = 1; sum += a + b; } }
            sum = wave_sum(sum); bad = __any(bad) ? 1 : 0;
            if (!(sum > 7.9f && sum < 8.1f)) bad = 1;
#elif DBG_CHECK == 3 || DBG_CHECK == 4
            const u32x4* gr = (DBG_CHECK == 3) ? (const u32x4*)(XN + (size_t)t * D) : (const u32x4*)(W_PP + (size_t)(t & 2047) * D);
            for (int i = 0; i < 8; ++i) { const u32x4 w = gr[i * 64 + lane];
                for (int e = 0; e < 4; ++e) { const float a = bf_lo(w[e]), b = bf_hi(w[e]); if (!(fabsf(a) < 1e30f) || !(fabsf(b) < 1e30f)) bad = 1; sum += a * a + b * b; } }
            sum = wave_sum(sum); bad = __any(bad) ? 1 : 0;
            if (DBG_CHECK == 3) { if (!(sum > 2048.f && sum < 8192.f)) bad = 1; } else { if (!(sum > 0.5f && sum < 2.0f)) bad = 1; }
#else
            const f32x4* sr4 = (const f32x4*)(SC + (size_t)t * 2048);
            for (int i = 0; i < 8; ++i) { const f32x4 w = sr4[i * 64 + lane]; for (int e = 0; e < 4; ++e) { if (!(fabsf(w[e]) < 1e4f)) bad = 1; sum += w[e] * w[e]; } }
            sum = wave_sum(sum); bad = __any(bad) ? 1 : 0;
            if (!(sum > 2048.f * 0.5f && sum < 2048.f * 2.0f)) bad = 1;
#endif
            if (bad) { f32x4* hr = (f32x4*)(hout + (size_t)t * D); for (int j = 0; j < 16; ++j) hr[64 * j + lane] = (f32x4){0.f, 0.f, 0.f, 0.f}; }
        }
    }
#endif
    if (IN(12)) {
        { int t_ = tid; asm volatile("" : "+v"(t_)); LAS f32x4* gl4 = (LAS f32x4*)(lds + PQ_OFF); const f32x4* gw4 = (const f32x4*)fin_w; gl4[t_] = gw4[t_]; gl4[t_ + 512] = gw4[t_ + 512]; }
        __syncthreads();
        int ln_ = (int)__builtin_amdgcn_mbcnt_hi(~0u, __builtin_amdgcn_mbcnt_lo(~0u, 0u)); asm volatile("" : "+v"(ln_));
        rms_rows_bf16_to_f32(XN, (const LAS float*)(lds + PQ_OFF), hout, gw, NGW, T, ln_); }
#undef IN
#undef SEAM
}

extern "C" void kernel_launch(void* const* d_in, const int* in_sizes, int n_in, void* d_out, int out_size, void* d_ws, size_t ws_size, hipStream_t stream) {
    static int grid = 0;
    if (grid == 0) {
        if (n_in != 18 || in_sizes[0] != T * D || out_size != T * D || ws_size < WS_END) { fprintf(stderr, "kernel_launch: unexpected shapes (n_in %d, in0 %d, out %d, ws %zu < %zu); nothing launched\n", n_in, n_in > 0 ? in_sizes[0] : -1, out_size, ws_size, (size_t)WS_END); grid = -1; return; }
        int dev = 0, cus = 0, per_cu = 0;
        if (hipGetDevice(&dev) != hipSuccess || hipDeviceGetAttribute(&cus, hipDeviceAttributeMultiprocessorCount, dev) != hipSuccess) { fprintf(stderr, "kernel_launch: device query failed\n"); grid = -1; return; }
        if (hipFuncSetAttribute((const void*)fwd, hipFuncAttributeMaxDynamicSharedMemorySize, LDS_BYTES) != hipSuccess) { fprintf(stderr, "kernel_launch: hipFuncSetAttribute failed\n"); grid = -1; return; }
        if (hipOccupancyMaxActiveBlocksPerMultiprocessor(&per_cu, (const void*)fwd, NWAVES * 64, LDS_BYTES) != hipSuccess || per_cu < 1) fprintf(stderr, "kernel_launch: note: occupancy query reports %d workgroups per CU\n", per_cu);
        (void)hipGetLastError();
        grid = cus;
    }
    if (grid < 0) return;
    if (hipMemsetAsync((char*)d_ws + WS_CTL, 0, CTL_ZERO_BYTES, stream) != hipSuccess) { fprintf(stderr, "kernel_launch: memset failed\n"); return; }
    Args a{};
    for (int i = 0; i < 18; ++i) a.in[i] = (const float*)d_in[i];
    a.out = (float*)d_out; a.ws = (unsigned char*)d_ws;
#if MK_PER_PHASE
    { const int order[] = { PROBE_ORDER }; const int subs[] = { PROBE_SUBS };
      for (unsigned q = 0; q < sizeof(order) / sizeof(int); ++q) { a.ph_lo = order[q]; a.ph_hi = order[q] + 1; a.sub = subs[q]; hipLaunchKernelGGL(fwd, dim3(grid), dim3(NWAVES * 64), LDS_BYTES, stream, a); } }
#else
    a.ph_lo = 0; a.ph_hi = NPHASE; a.sub = 7; hipLaunchKernelGGL(fwd, dim3(grid), dim3(NWAVES * 64), LDS_BYTES, stream, a);
#endif
    const hipError_t le = hipPeekAtLastError();
    if (le != hipSuccess) fprintf(stderr, "kernel_launch: launch failed: %s\n", hipGetErrorName(le));
}
```
